# Optimizing an MI355X kernel written in HIP

```python
import math
import jax, jax.numpy as jnp
from jax import lax
import numpy as np

D_MODEL = 2048
BATCH = 8
SEQ = 2048
DEPTH = 4

HEAD_DIM = 64
N_MIXERS = 4
GROUP_WIDTH = D_MODEL // N_MIXERS
N_HEADS = GROUP_WIDTH // HEAD_DIM
NSA_KV_HEADS = 2
NSA_GQA = N_HEADS // NSA_KV_HEADS
CMP_LEN = 32
CMP_STRIDE = 16
SLC_LEN = 64
SLC_TOP = 16
WINDOW = 512
FORCE_BONUS = 1.0e3
N_BUCKETS = 32
MAX_DISTANCE = 1024
CONV_W = 3
CHUNK = 128
Q_BLOCK = 128
D_FF = -(-8 * D_MODEL // (3 * 256)) * 256
NEG_INF = -1.0e30

A_Q_COLS = N_HEADS * HEAD_DIM
A_KV_COLS = 6 * NSA_KV_HEADS * HEAD_DIM
A_GATE_COLS = 3 * N_HEADS
B_COLS = 3 * GROUP_WIDTH
C_COLS = 2 * GROUP_WIDTH
D_COLS = 3 * GROUP_WIDTH
SPLIT_POINTS = (A_Q_COLS, A_Q_COLS + A_KV_COLS, A_Q_COLS + A_KV_COLS + A_GATE_COLS, A_Q_COLS + A_KV_COLS + A_GATE_COLS + B_COLS, A_Q_COLS + A_KV_COLS + A_GATE_COLS + B_COLS + C_COLS)
W_IN_COLS = SPLIT_POINTS[-1] + D_COLS

kernel_name = 'hybrid_nsa_conv_sgu_stickbreak'


def rms_norm(x, g, eps=1e-6):
    xf = x.astype(jnp.float32)
    y = xf * lax.rsqrt(jnp.mean(xf * xf, axis=-1, keepdims=True) + eps)
    return (y * g.astype(jnp.float32)).astype(x.dtype)


def layer_norm_noaffine(x, eps=1e-5):
    xf = x.astype(jnp.float32)
    mu = jnp.mean(xf, axis=-1, keepdims=True)
    var = jnp.mean(jnp.square(xf - mu), axis=-1, keepdims=True)
    return ((xf - mu) * lax.rsqrt(var + eps)).astype(x.dtype)


def gelu(x):
    return jax.nn.gelu(x, approximate=True)


def rel_bucket(dist):
    n = jnp.maximum(dist, 0)
    max_exact = N_BUCKETS // 2
    nf = jnp.maximum(n, 1).astype(jnp.float32)
    large = max_exact + (jnp.log(nf / max_exact) / math.log(MAX_DISTANCE / max_exact) * (N_BUCKETS - max_exact)).astype(jnp.int32)
    large = jnp.minimum(large, N_BUCKETS - 1)
    return jnp.where(n < max_exact, n, large)


def rel_bias_heads(dist, table):
    b = table[rel_bucket(dist)].astype(jnp.float32)
    b = jnp.moveaxis(b, -1, 0)
    return b.reshape(NSA_KV_HEADS, NSA_GQA, *dist.shape)


def masked_softmax(s, mask):
    s = jnp.where(mask, s, NEG_INF)
    p = jax.nn.softmax(s, axis=-1)
    return jnp.where(mask, p, 0.0)


def cmp_slc_overlap(n_cmp, n_slc):
    c0 = np.arange(n_cmp)[:, None] * CMP_STRIDE
    s0 = np.arange(n_slc)[None, :] * SLC_LEN
    ov = np.minimum(c0 + CMP_LEN, s0 + SLC_LEN) - np.maximum(c0, s0)
    return (np.maximum(ov, 0) / CMP_LEN).astype(np.float32)


def nsa_attention(q, k_c, v_c, k_s, v_s, k_w, v_w, gates, q_gain, k_gain, cmp_pos, cmp_w1, cmp_w2, rel_table):
    B, T = q.shape[0], q.shape[1]
    G, R, Dh = NSA_KV_HEADS, NSA_GQA, HEAD_DIM
    scale = Dh ** -0.5
    q = rms_norm(q, q_gain).reshape(B, T, G, R, Dh)
    k_s = rms_norm(k_s, k_gain)
    k_w = rms_norm(k_w, k_gain)
    t_pos = jnp.arange(T, dtype=jnp.int32)

    n_cmp = (T - CMP_LEN) // CMP_STRIDE + 1
    blk = np.arange(n_cmp)[:, None] * CMP_STRIDE + np.arange(CMP_LEN)[None, :]

    def compress(z, i):
        zb = z[:, blk] + cmp_pos[i][None, None, :, None, :]
        zb = zb.transpose(0, 1, 3, 2, 4).reshape(B, n_cmp, G, CMP_LEN * Dh)
        return gelu(zb @ cmp_w1[i]) @ cmp_w2[i]

    kc = rms_norm(compress(k_c, 0), k_gain)
    vc = compress(v_c, 1)
    cmp_end = jnp.asarray(blk[:, -1], jnp.int32)
    dist_c = t_pos[:, None] - cmp_end[None, :]
    s_c = jnp.einsum('btgrd,bngd->bgrtn', q, kc).astype(jnp.float32) * scale + rel_bias_heads(dist_c, rel_table)
    p_c = masked_softmax(s_c, dist_c >= 0)
    o_cmp = jnp.einsum('bgrtn,bngd->btgrd', p_c.astype(vc.dtype), vc)

    n_slc = T // SLC_LEN
    top = min(SLC_TOP, n_slc)
    imp = jnp.einsum('bgrtn,nj->bgtj', p_c, jnp.asarray(cmp_slc_overlap(n_cmp, n_slc)))
    j_idx = jnp.arange(n_slc, dtype=jnp.int32)
    cur = t_pos // SLC_LEN
    valid = (j_idx[None, :] * SLC_LEN) <= t_pos[:, None]
    forced = (j_idx[None, :] == 0) | (j_idx[None, :] == cur[:, None]) | (j_idx[None, :] == cur[:, None] - 1)
    score = jnp.where(valid, imp + jnp.where(forced, FORCE_BONUS, 0.0), NEG_INF)
    _, sel = lax.top_k(score, top)

    ks_blk = k_s.reshape(B, n_slc, SLC_LEN, G, Dh).transpose(0, 3, 1, 2, 4)
    vs_blk = v_s.reshape(B, n_slc, SLC_LEN, G, Dh).transpose(0, 3, 1, 2, 4)
    pad = ((0, 0), (WINDOW, 0), (0, 0), (0, 0))
    kw_pad = jnp.pad(k_w, pad)
    vw_pad = jnp.pad(v_w, pad)
    table_g = rel_table.reshape(N_BUCKETS, G, R)
    g_idx = jnp.arange(G)[None, :, None, None, None]
    gather_blocks = jax.vmap(jax.vmap(lambda blocks, ix: blocks[ix]))
    win_len = WINDOW + Q_BLOCK

    def block_fn(qb):
        qs = qb * Q_BLOCK
        qt = qs + jnp.arange(Q_BLOCK, dtype=jnp.int32)
        qblk = lax.dynamic_slice_in_dim(q, qs, Q_BLOCK, axis=1)
        ix = lax.dynamic_slice_in_dim(sel, qs, Q_BLOCK, axis=2)
        ksel = gather_blocks(ks_blk, ix)
        vsel = gather_blocks(vs_blk, ix)
        kpos = ix[..., None] * SLC_LEN + jnp.arange(SLC_LEN, dtype=jnp.int32)
        d_s = qt[None, None, :, None, None] - kpos
        b_s = jnp.moveaxis(table_g[rel_bucket(d_s), g_idx].astype(jnp.float32), -1, 2)
        s_s = jnp.einsum('btgrd,bgtkld->bgrtkl', qblk, ksel).astype(jnp.float32) * scale + b_s
        shp = s_s.shape
        p_s = masked_softmax(s_s.reshape(B, G, R, Q_BLOCK, -1), (d_s >= 0).reshape(B, G, 1, Q_BLOCK, -1)).reshape(shp)
        o_s = jnp.einsum('bgrtkl,bgtkld->btgrd', p_s.astype(vsel.dtype), vsel)
        kw = lax.dynamic_slice_in_dim(kw_pad, qs, win_len, axis=1)
        vw = lax.dynamic_slice_in_dim(vw_pad, qs, win_len, axis=1)
        kp = qs - WINDOW + jnp.arange(win_len, dtype=jnp.int32)
        d_w = qt[:, None] - kp[None, :]
        m_w = (d_w >= 0) & (d_w < WINDOW) & (kp[None, :] >= 0)
        s_w = jnp.einsum('btgrd,bsgd->bgrts', qblk, kw).astype(jnp.float32) * scale + rel_bias_heads(d_w, rel_table)
        p_w = masked_softmax(s_w, m_w)
        o_w = jnp.einsum('bgrts,bsgd->btgrd', p_w.astype(vw.dtype), vw)
        return o_s, o_w

    o_slc, o_win = lax.map(block_fn, jnp.arange(T // Q_BLOCK, dtype=jnp.int32))
    o_slc = jnp.moveaxis(o_slc, 0, 1).reshape(B, T, G, R, Dh)
    o_win = jnp.moveaxis(o_win, 0, 1).reshape(B, T, G, R, Dh)

    g = jax.nn.sigmoid(gates.astype(jnp.float32)).astype(q.dtype).reshape(B, T, G, R, 3)
    o = g[..., 0:1] * o_cmp + g[..., 1:2] * o_slc + g[..., 2:3] * o_win
    return o.reshape(B, T, G * R * Dh)


def short_conv_mixer(cols, conv_w):
    b_gate, c_gate, h = jnp.split(cols, 3, axis=-1)
    z = c_gate * h
    T = z.shape[1]
    zp = jnp.pad(z, ((0, 0), (CONV_W - 1, 0), (0, 0)))
    y = conv_w[0] * zp[:, 0:T]
    for i in range(1, CONV_W):
        y = y + conv_w[i] * zp[:, i:i + T]
    return b_gate * y


def spatial_gating_mixer(cols, sgu_w, sgu_b):
    B, T = cols.shape[0], cols.shape[1]
    u, v = jnp.split(gelu(cols), 2, axis=-1)
    v = layer_norm_noaffine(v).reshape(B, T // CHUNK, CHUNK, N_HEADS, HEAD_DIM)
    w = sgu_w * jnp.asarray(np.tril(np.ones((CHUNK, CHUNK), np.float32)), sgu_w.dtype)
    s = jnp.einsum('hpq,bcqhe->bcphe', w, v) + sgu_b.T[None, None, :, :, None]
    return u * s.reshape(B, T, GROUP_WIDTH)


def stick_breaking_attention(q, k, v):
    B, T, H, Dh = q.shape
    scale = Dh ** -0.5
    outs = []
    for qb in range(T // Q_BLOCK):
        qs, qe = qb * Q_BLOCK, (qb + 1) * Q_BLOCK
        z = jnp.einsum('bthd,bshd->bhts', q[:, qs:qe], k[:, :qe]).astype(jnp.float32) * scale
        mask = jnp.asarray(np.arange(qe)[None, :] < np.arange(qs, qe)[:, None])
        log_beta = jax.nn.log_sigmoid(z)
        log_1m = jnp.where(mask, log_beta - z, 0.0)
        tail = lax.cumsum(log_1m, axis=3, reverse=True) - log_1m
        a = jnp.where(mask, jnp.exp(log_beta + tail), 0.0)
        outs.append(jnp.einsum('bhts,bshd->bthd', a.astype(v.dtype), v[:, :qe]))
    return jnp.concatenate(outs, axis=1).reshape(B, T, H * Dh)


def setup_inputs(seed: int = 0) -> dict:
    key = jax.random.key(seed)
    ks = jax.random.split(key, 18)
    f32 = jnp.float32

    def nrm(k, shape, scale):
        return jax.random.normal(k, shape, f32) * scale

    res_scale = (2 * DEPTH) ** -0.5
    return {
        'x': nrm(ks[0], (BATCH, SEQ, D_MODEL), 1.0),
        'w_in': nrm(ks[1], (DEPTH, D_MODEL, W_IN_COLS), D_MODEL ** -0.5),
        'w_out': nrm(ks[2], (DEPTH, D_MODEL, D_MODEL), D_MODEL ** -0.5 * res_scale),
        'norm_mix': 1.0 + nrm(ks[3], (DEPTH, D_MODEL), 0.05),
        'norm_ffn': 1.0 + nrm(ks[4], (DEPTH, D_MODEL), 0.05),
        'q_gain': 1.0 + nrm(ks[5], (DEPTH, HEAD_DIM), 0.05),
        'k_gain': 1.0 + nrm(ks[6], (DEPTH, HEAD_DIM), 0.05),
        'cmp_pos': nrm(ks[7], (DEPTH, 2, CMP_LEN, HEAD_DIM), 0.1),
        'cmp_w1': nrm(ks[8], (DEPTH, 2, CMP_LEN * HEAD_DIM, HEAD_DIM), (CMP_LEN * HEAD_DIM) ** -0.5),
        'cmp_w2': nrm(ks[9], (DEPTH, 2, HEAD_DIM, HEAD_DIM), HEAD_DIM ** -0.5),
        'rel_table': nrm(ks[10], (N_BUCKETS, N_HEADS), 0.5),
        'conv_w': nrm(ks[11], (DEPTH, CONV_W, GROUP_WIDTH), CONV_W ** -0.5),
        'sgu_w': nrm(ks[12], (DEPTH, N_HEADS, CHUNK, CHUNK), CHUNK ** -0.5),
        'sgu_b': 1.0 + nrm(ks[13], (DEPTH, N_HEADS, CHUNK), 0.1),
        'group_gain': 1.0 + nrm(ks[14], (DEPTH, D_MODEL), 0.05),
        'w_ffn_gate': nrm(ks[15], (DEPTH, D_MODEL, D_FF), D_MODEL ** -0.5),
        'w_ffn_up': nrm(ks[16], (DEPTH, D_MODEL, D_FF), D_MODEL ** -0.5),
        'w_ffn_down': nrm(ks[17], (DEPTH, D_FF, D_MODEL), D_FF ** -0.5 * res_scale),
    }


def reference(x, w_in, w_out, norm_mix, norm_ffn, q_gain, k_gain, cmp_pos, cmp_w1, cmp_w2, rel_table, conv_w, sgu_w, sgu_b, group_gain, w_ffn_gate, w_ffn_up, w_ffn_down):
    B, T = x.shape[0], x.shape[1]
    for l in range(DEPTH):
        h = rms_norm(x, norm_mix[l])
        proj = h @ w_in[l]
        a_q, a_kv, a_g, b_cols, c_cols, d_cols = jnp.split(proj, SPLIT_POINTS, axis=-1)
        kv = a_kv.reshape(B, T, 6, NSA_KV_HEADS, HEAD_DIM)
        o_a = nsa_attention(a_q.reshape(B, T, N_HEADS, HEAD_DIM), kv[:, :, 0], kv[:, :, 1], kv[:, :, 2], kv[:, :, 3], kv[:, :, 4], kv[:, :, 5], a_g.reshape(B, T, N_HEADS, 3), q_gain[l], k_gain[l], cmp_pos[l], cmp_w1[l], cmp_w2[l], rel_table)
        o_b = short_conv_mixer(b_cols, conv_w[l])
        o_c = spatial_gating_mixer(c_cols, sgu_w[l], sgu_b[l])
        dq, dk, dv = jnp.split(d_cols, 3, axis=-1)
        o_d = stick_breaking_attention(dq.reshape(B, T, N_HEADS, HEAD_DIM), dk.reshape(B, T, N_HEADS, HEAD_DIM), dv.reshape(B, T, N_HEADS, HEAD_DIM))
        mixed = jnp.stack([o_a, o_b, o_c, o_d], axis=2)
        mixed = rms_norm(mixed, group_gain[l].reshape(N_MIXERS, GROUP_WIDTH))
        x = x + mixed.reshape(B, T, D_MODEL) @ w_out[l]
        h = rms_norm(x, norm_ffn[l])
        x = x + (jax.nn.silu(h @ w_ffn_gate[l]) * (h @ w_ffn_up[l])) @ w_ffn_down[l]
    return x
```

```cpp
#include <hip/hip_runtime.h>
#include <hip/hip_cooperative_groups.h>
#include <cstdio>
#include <cstdint>
namespace cg = cooperative_groups;
__device__ __forceinline__ int otid() { int t = threadIdx.x; asm volatile("" : "+v"(t)); return t; }
namespace pg8 {
#define PG8_LAS __attribute__((address_space(3)))
typedef unsigned short bf16_t;
typedef short bf16x8 __attribute__((ext_vector_type(8)));
typedef float f32x4 __attribute__((ext_vector_type(4)));
typedef unsigned u32x4 __attribute__((ext_vector_type(4)));
constexpr int BM = 256, BK = 64, HALF = 128, HTB = HALF * BK * 2  , STAGE_BYTES = 8 * HTB, NXCD = 8, WGM = 8;

__host__ __device__ __forceinline__ int lds_byte(int r, int c) { const int st = (r >> 4) * 2 + (c >> 5), rr = r & 15, cc = c & 31, ob = rr * 64 + cc * 2; return st * 1024 + (ob ^ (((ob >> 9) & 1) << 5)); }
__host__ __device__ __forceinline__ void stage_rc(int b, int& R, int& C) { const int st = b / 1024, sb = b % 1024, swz = sb ^ (((sb >> 9) & 1) << 5); R = (st >> 1) * 16 + swz / 64; C = (st & 1) * 32 + (swz % 64) / 2; }
__host__ __device__ __forceinline__ int perm32(int rho) { const int n = rho >> 4, i = rho & 15; return 8 * (i >> 2) + 4 * n + (i & 3); }

struct Unit { int pm, pn; };
struct Gemm { const bf16_t* A; const bf16_t* Bt; int M, N, K; };

struct StaticOrder {
    int nM, nN, nwg, G, c;
    __host__ __device__ void init(int M, int N, int G_, int c_) { nM = M / BM; nN = N / BM; nwg = nM * nN; G = G_; c = c_; }
    __host__ __device__ bool next(int i, Unit& u) const {
        const long L = (long)i * G + c; if (L >= nwg) return false;
        int wgid = (int)L; { const int q = nwg / NXCD, r = nwg % NXCD, xcd = wgid % NXCD, off = wgid / NXCD; wgid = (xcd < r ? xcd * (q + 1) : r * (q + 1) + (xcd - r) * q) + off; }
        const int nig = WGM * nN, gid = wgid / nig, fm = gid * WGM, gsz = (nM - fm) < WGM ? (nM - fm) : WGM;
        u.pm = fm + ((wgid % nig) % gsz); u.pn = (wgid % nig) / gsz; return true;
    }
    __device__ __forceinline__ void a_ready(const Unit&) const {}
    __device__ __forceinline__ void done(const Unit&) const {}
};

__device__ __forceinline__ unsigned cvt_pk_bf16(float lo, float hi) { unsigned r; asm volatile("v_cvt_pk_bf16_f32 %0, %1, %2" : "=v"(r) : "v"(lo), "v"(hi)); return r; }
template <class Epi, class Sched, bool ALIGN_EPI = false, bool SP2 = false>
__device__ __forceinline__ void gemm_phase(PG8_LAS unsigned char* lds, const Gemm g, const Sched& S, const Epi& E) {
    const int tid = otid(), wid = __builtin_amdgcn_readfirstlane(tid >> 6), lane = tid & 63, wr = wid >> 2, wc = wid & 3, fr = lane & 15, fq = lane >> 4;
    const int K = g.K, nt = K / BK;
    unsigned voffA[2], voffB[2];
#pragma unroll
    for (int i = 0; i < 2; ++i) { int R, C; stage_rc(tid * 16 + i * 8192, R, C); const int Rb = Epi::PERM ? ((R & ~31) + perm32(R & 31)) : R;
        voffA[i] = (unsigned)(R * K + C) * 2u; voffB[i] = (unsigned)(Rb * K + C) * 2u; }
    const size_t kstep = (size_t)(BK * 2);
    const size_t hstep = (size_t)HALF * K * 2;
    const size_t tstep = 2 * hstep;
    const unsigned ldsw = (unsigned)wid * 1024u;
    const int aoff = lds_byte(wr * 64 + fr, fq * 8), boff = lds_byte(wc * 32 + fr, fq * 8);
#define PG8_SA(b, h) (((b) * 2 + (h)) * HTB)
#define PG8_SB(b, h) ((4 + (b) * 2 + (h)) * HTB)
#define PG8_STAGE(bufoff, gbase, voff) do { _Pragma("unroll") for (int _i = 0; _i < 2; ++_i) \
        __builtin_amdgcn_global_load_lds((const unsigned*)((const char*)(gbase) + (voff)[_i]), (PG8_LAS unsigned*)(lds + (bufoff) + ldsw + _i * 8192), 16, 0, 0); } while (0)
#define PG8_LDA(dst, b, h) do { _Pragma("unroll") for (int m = 0; m < 4; ++m) _Pragma("unroll") for (int k = 0; k < 2; ++k) dst[m][k] = *(const PG8_LAS bf16x8*)(lds + PG8_SA(b, h) + aoff + m * 2048 + k * 1024); } while (0)
#define PG8_LDB(dst, b, h) do { _Pragma("unroll") for (int n = 0; n < 2; ++n) _Pragma("unroll") for (int k = 0; k < 2; ++k) dst[n][k] = *(const PG8_LAS bf16x8*)(lds + PG8_SB(b, h) + boff + n * 2048 + k * 1024); } while (0)
#define PG8_MMA(ai, bj, At, Bt) do { __builtin_amdgcn_s_setprio(1); _Pragma("unroll") for (int m = 0; m < 4; ++m) _Pragma("unroll") for (int n = 0; n < 2; ++n) _Pragma("unroll") for (int k = 0; k < 2; ++k) \
        acc[ai][bj][m][n] = __builtin_amdgcn_mfma_f32_16x16x32_bf16(Bt[n][k], At[m][k], acc[ai][bj][m][n], 0, 0, 0); __builtin_amdgcn_s_setprio(0); } while (0)
#define PG8_WAIT_V(n) asm volatile("s_waitcnt vmcnt(" #n ")" ::: "memory")
#define PG8_WAIT_L(n) asm volatile("s_waitcnt lgkmcnt(" #n ")" ::: "memory")
#define PG8_BAR __builtin_amdgcn_s_barrier()
#define PG8_SCHED __builtin_amdgcn_sched_barrier(0)
    Unit cur, nxt; int ui = 0;
    if (!S.next(0, cur)) return;
    f32x4 acc[2][2][4][2];
#pragma unroll
    for (int a = 0; a < 2; ++a)
#pragma unroll
        for (int b = 0; b < 2; ++b)
#pragma unroll
            for (int m = 0; m < 4; ++m)
#pragma unroll
                for (int n = 0; n < 2; ++n) acc[a][b][m][n] = (f32x4){0.f, 0.f, 0.f, 0.f};
    bf16x8 At[4][2], B0[2][2], B1[2][2];
    const char* cA = (const char*)g.A + (size_t)cur.pm * tstep; const char* cB = (const char*)g.Bt + (size_t)cur.pn * tstep;
    S.a_ready(cur);
    if constexpr (SP2) {
        PG8_STAGE(PG8_SB(0, 0), cB, voffB); PG8_STAGE(PG8_SB(0, 1), cB + hstep, voffB); PG8_STAGE(PG8_SA(0, 0), cA, voffA); PG8_STAGE(PG8_SA(0, 1), cA + hstep, voffA);
        if (wr == 1) PG8_BAR;
        PG8_WAIT_V(2); PG8_BAR;
        PG8_STAGE(PG8_SB(1, 0), cB + kstep, voffB); PG8_STAGE(PG8_SA(1, 0), cA + kstep, voffA); PG8_STAGE(PG8_SB(1, 1), cB + hstep + kstep, voffB);
        PG8_WAIT_V(6); PG8_BAR;
    } else {
        PG8_STAGE(PG8_SB(0, 0), cB, voffB); PG8_STAGE(PG8_SA(0, 0), cA, voffA); PG8_STAGE(PG8_SB(0, 1), cB + hstep, voffB); PG8_STAGE(PG8_SA(0, 1), cA + hstep, voffA);
        if (wr == 1) PG8_BAR;
        PG8_WAIT_V(4); PG8_BAR;
        PG8_STAGE(PG8_SB(1, 0), cB + kstep, voffB); PG8_STAGE(PG8_SA(1, 0), cA + kstep, voffA); PG8_STAGE(PG8_SB(1, 1), cB + hstep + kstep, voffB);
        PG8_WAIT_V(6); PG8_BAR;
    }
    for (;;) {
        const bool has_next = S.next(ui + 1, nxt);
        const char* nA = has_next ? (const char*)g.A + (size_t)nxt.pm * tstep : cA; const char* nB = has_next ? (const char*)g.Bt + (size_t)nxt.pn * tstep : cB;
        for (int t = 0; t < nt; t += 2) {
            const bool last = (t == nt - 2);
            const char* a1 = cA + (size_t)(t + 1) * kstep;
            const char* a2 = last ? nA : cA + (size_t)(t + 2) * kstep; const char* b2 = last ? nB : cB + (size_t)(t + 2) * kstep;
            const char* a3 = a2 + kstep; const char* b3 = b2 + kstep;
            if (last && has_next) S.a_ready(nxt);
            if constexpr (SP2) {
            PG8_LDB(B0, 0, 0); PG8_LDB(B1, 0, 1); PG8_SCHED; PG8_LDA(At, 0, 0); PG8_STAGE(PG8_SA(1, 1), a1 + hstep, voffA);
            PG8_WAIT_V(8); PG8_WAIT_L(0); PG8_BAR; PG8_MMA(0, 0, At, B0); PG8_MMA(0, 1, At, B1); PG8_BAR; PG8_SCHED;
            PG8_LDA(At, 0, 1); PG8_STAGE(PG8_SB(0, 0), b2, voffB); PG8_STAGE(PG8_SB(0, 1), b2 + hstep, voffB); PG8_STAGE(PG8_SA(0, 0), a2, voffA);
            PG8_WAIT_V(8); PG8_WAIT_L(0); PG8_BAR; PG8_MMA(1, 0, At, B0); PG8_MMA(1, 1, At, B1); PG8_BAR; PG8_SCHED;
            PG8_LDB(B0, 1, 0); PG8_LDB(B1, 1, 1); PG8_SCHED; PG8_LDA(At, 1, 0); PG8_STAGE(PG8_SA(0, 1), a2 + hstep, voffA);
            PG8_WAIT_V(8); PG8_WAIT_L(0); PG8_BAR; PG8_MMA(0, 0, At, B0); PG8_MMA(0, 1, At, B1); PG8_BAR; PG8_SCHED;
            PG8_LDA(At, 1, 1); PG8_STAGE(PG8_SB(1, 0), b3, voffB); PG8_STAGE(PG8_SB(1, 1), b3 + hstep, voffB); PG8_STAGE(PG8_SA(1, 0), a3, voffA);
            PG8_WAIT_V(8); PG8_WAIT_L(0); PG8_BAR; PG8_MMA(1, 0, At, B0); PG8_MMA(1, 1, At, B1); PG8_BAR; PG8_SCHED;
            } else {
            PG8_LDB(B0, 0, 0); PG8_SCHED; PG8_LDA(At, 0, 0); PG8_STAGE(PG8_SA(1, 1), a1 + hstep, voffA);
            PG8_WAIT_L(8); PG8_BAR; PG8_WAIT_L(0); PG8_MMA(0, 0, At, B0); PG8_BAR; PG8_SCHED;
            PG8_LDB(B1, 0, 1); PG8_STAGE(PG8_SB(0, 0), b2, voffB);
            PG8_BAR; PG8_WAIT_L(0); PG8_MMA(0, 1, At, B1); PG8_BAR;
            PG8_LDA(At, 0, 1); PG8_STAGE(PG8_SA(0, 0), a2, voffA);
            PG8_BAR; PG8_WAIT_L(0); PG8_MMA(1, 0, At, B0); PG8_BAR; PG8_SCHED;
            PG8_STAGE(PG8_SB(0, 1), b2 + hstep, voffB);
            PG8_WAIT_V(6); PG8_BAR; PG8_MMA(1, 1, At, B1); PG8_BAR;
            PG8_LDB(B0, 1, 0); PG8_SCHED; PG8_LDA(At, 1, 0); PG8_STAGE(PG8_SA(0, 1), a2 + hstep, voffA);
            PG8_WAIT_L(8); PG8_BAR; PG8_WAIT_L(0); PG8_MMA(0, 0, At, B0); PG8_BAR; PG8_SCHED;
            PG8_LDB(B1, 1, 1); PG8_STAGE(PG8_SB(1, 0), b3, voffB);
            PG8_BAR; PG8_WAIT_L(0); PG8_MMA(0, 1, At, B1); PG8_BAR;
            PG8_LDA(At, 1, 1); PG8_STAGE(PG8_SA(1, 0), a3, voffA);
            PG8_BAR; PG8_WAIT_L(0); PG8_MMA(1, 0, At, B0); PG8_BAR; PG8_SCHED;
            PG8_STAGE(PG8_SB(1, 1), b3 + hstep, voffB);
            PG8_WAIT_V(6); PG8_BAR; PG8_MMA(1, 1, At, B1); PG8_BAR;
            }
        }
        if constexpr (ALIGN_EPI) { if (wr == 0) PG8_BAR; }
        if constexpr (!Epi::AFTER_DRAIN) { E(acc, cur, wr, wc, fr, fq); S.done(cur); }
        if (!has_next) break;
#pragma unroll
        for (int a = 0; a < 2; ++a)
#pragma unroll
            for (int b = 0; b < 2; ++b)
#pragma unroll
                for (int m = 0; m < 4; ++m)
#pragma unroll
                    for (int n = 0; n < 2; ++n) acc[a][b][m][n] = (f32x4){0.f, 0.f, 0.f, 0.f};
        cur = nxt; cA = nA; cB = nB; ++ui;
        if constexpr (ALIGN_EPI) { if (wr == 1) PG8_BAR; }
    }
    PG8_WAIT_V(0);
    if constexpr (!ALIGN_EPI) { if (wr == 0) PG8_BAR; }
    PG8_BAR;
    if constexpr (Epi::AFTER_DRAIN) { E.fused(acc, cur, wr, wc, fr, fq, lds, wid, lane); S.done(cur); }
#undef PG8_SA
#undef PG8_SB
#undef PG8_STAGE
#undef PG8_LDA
#undef PG8_LDB
#undef PG8_MMA
#undef PG8_WAIT_V
#undef PG8_WAIT_L
#undef PG8_BAR
#undef PG8_SCHED
}
}
using pg8::bf16_t; using pg8::bf16x8; using pg8::f32x4; using pg8::u32x4; using pg8::cvt_pk_bf16;
typedef float f32x16 __attribute__((ext_vector_type(16)));
typedef unsigned u32x2 __attribute__((ext_vector_type(2)));
#define LAS __attribute__((address_space(3)))

constexpr int T = 2048, MROWS = 16384, DM = 2048, NPJ = 5632, DFF = 5632, NGU = 11264, NIN = 5400;
constexpr int C_KC = 512, C_VC = 640, C_KS = 768, C_VS = 896, C_KW = 1024, C_VW = 1152, C_AG = 1280, C_BG = 1304, C_CG = 1816, C_BH = 2328,
              C_CU = 2840, C_CV = 3352, C_DQ = 3864, C_DK = 4376, C_DV = 4888;
constexpr int LDS_BYTES = 159744;

constexpr size_t WS_WIN = 0;
constexpr size_t WS_WOUT = WS_WIN + (size_t)NPJ * DM * 2;
constexpr size_t WS_WGU = WS_WOUT + (size_t)DM * DM * 2;
constexpr size_t WS_WDN = WS_WGU + (size_t)NGU * DM * 2;
constexpr size_t WS_ABUF = WS_WDN + (size_t)DM * DFF * 2;
constexpr size_t WS_PROJ = WS_ABUF + (size_t)MROWS * DM * 2;
constexpr size_t WS_MIX = WS_PROJ + (size_t)MROWS * NPJ * 4;
constexpr size_t WS_QN = WS_MIX + (size_t)MROWS * DM * 4;
constexpr size_t WS_KS = WS_QN + (size_t)MROWS * 512 * 2;
constexpr size_t WS_KW = WS_KS + (size_t)MROWS * 128 * 2;
constexpr size_t WS_VST = WS_KW + (size_t)MROWS * 128 * 2;
constexpr size_t WS_VWT = WS_VST + (size_t)MROWS * 128 * 2;
constexpr size_t WS_KCN = WS_VWT + (size_t)MROWS * 128 * 2;
constexpr size_t WS_VCT = WS_KCN + (size_t)16 * 128 * 64 * 2;
constexpr size_t WS_DQ = WS_VCT + (size_t)16 * 128 * 64 * 2;
constexpr size_t WS_DK = WS_DQ + (size_t)MROWS * 512 * 2;
constexpr size_t WS_DVT = WS_DK + (size_t)MROWS * 512 * 2;
constexpr size_t WS_MSK = WS_DVT + (size_t)MROWS * 512 * 2;
constexpr size_t WS_BAR = WS_MSK + (size_t)16 * 2048 * 4;
constexpr size_t WS_END = WS_BAR + 32768;

struct Params { const float* in[18]; float* out; unsigned char* ws; int ph_lo, ph_hi; };
enum { I_X = 0, I_WIN, I_WOUT, I_NMIX, I_NFFN, I_QG, I_KG, I_CPOS, I_CW1, I_CW2, I_REL, I_CONV, I_SGW, I_SGB, I_GG, I_WG, I_WU, I_WD };

__device__ __forceinline__ float wave_sum(float v) {
#pragma unroll
    for (int o = 1; o < 64; o <<= 1) v += __shfl_xor(v, o);
    return v;
}
__device__ __forceinline__ float gelu_tanh(float x) {
    const float u = 0.7978845608028654f * (x + 0.044715f * x * x * x);
    const float e = __expf(2.f * u);
    const float th = 1.f - 2.f / (e + 1.f);
    return 0.5f * x * (1.f + th);
}
__device__ __forceinline__ float sigmoidf_(float x) { return 1.f / (1.f + __expf(-x)); }
__device__ __forceinline__ bf16x8 pack8(float a0, float a1, float a2, float a3, float a4, float a5, float a6, float a7) {
    u32x4 w; w.x = cvt_pk_bf16(a0, a1); w.y = cvt_pk_bf16(a2, a3); w.z = cvt_pk_bf16(a4, a5); w.w = cvt_pk_bf16(a6, a7);
    return __builtin_bit_cast(bf16x8, w);
}
__device__ __forceinline__ float bf2f(bf16_t b) { return __uint_as_float((unsigned)b << 16); }
__device__ __forceinline__ float bflo(unsigned u) { return __uint_as_float(u << 16); }
__device__ __forceinline__ float bfhi(unsigned u) { return __uint_as_float(u & 0xffff0000u); }
struct F8 { f32x4 a, b; };
__device__ __forceinline__ F8 ld8(const bf16_t* p) {
    const u32x4 w = *(const u32x4*)p; F8 r;
    r.a = (f32x4){bflo(w.x), bfhi(w.x), bflo(w.y), bfhi(w.y)}; r.b = (f32x4){bflo(w.z), bfhi(w.z), bflo(w.w), bfhi(w.w)}; return r;
}
__device__ __forceinline__ F8 up8(const u32x4 w) { F8 r; r.a = (f32x4){bflo(w.x), bfhi(w.x), bflo(w.y), bfhi(w.y)}; r.b = (f32x4){bflo(w.z), bfhi(w.z), bflo(w.w), bfhi(w.w)}; return r; }
__device__ __forceinline__ bf16_t bf1(float a) { return (bf16_t)(cvt_pk_bf16(a, 0.f) & 0xffffu); }
__device__ __forceinline__ f32x16 mfma32(bf16x8 a, bf16x8 b, f32x16 c) { return __builtin_amdgcn_mfma_f32_32x32x16_bf16(a, b, c, 0, 0, 0); }
__device__ __forceinline__ int slot16(int ko) { return ((ko >> 2) & 1) * 8 + (ko >> 3) * 4 + (ko & 3); }

struct EpiF32 {
    static constexpr bool PERM = true, AFTER_DRAIN = false; bf16_t* O; int ldc;
    __device__ __forceinline__ void operator()(const f32x4 (&acc)[2][2][4][2], const pg8::Unit& u, int wr, int wc, int fr, int fq) const {
#pragma unroll
        for (int ai = 0; ai < 2; ++ai)
#pragma unroll
            for (int m = 0; m < 4; ++m) {
                bf16_t* rp = O + (size_t)(u.pm * 256 + ai * 128 + wr * 64 + m * 16 + fr) * ldc + u.pn * 256 + wc * 32 + fq * 8;
#pragma unroll
                for (int bj = 0; bj < 2; ++bj) {
                    const f32x4 v0 = acc[ai][bj][m][0], v1 = acc[ai][bj][m][1]; u32x4 w;
                    w.x = cvt_pk_bf16(v0[0], v0[1]); w.y = cvt_pk_bf16(v0[2], v0[3]); w.z = cvt_pk_bf16(v1[0], v1[1]); w.w = cvt_pk_bf16(v1[2], v1[3]);
                    *(u32x4*)(rp + bj * 128) = w;
                }
            }
    }
};
struct EpiResid {
    static constexpr bool PERM = true, AFTER_DRAIN = false; const float* base; float* out; int ldc;
    __device__ __forceinline__ void operator()(const f32x4 (&acc)[2][2][4][2], const pg8::Unit& u, int wr, int wc, int fr, int fq) const {
        const size_t off0 = (size_t)(u.pm * 256 + wr * 64 + fr) * ldc + u.pn * 256 + wc * 32 + fq * 8;
        f32x4 cur[2][2], nxt[2][2];
#pragma unroll
        for (int bj = 0; bj < 2; ++bj) { cur[bj][0] = *(const f32x4*)(base + off0 + bj * 128); cur[bj][1] = *(const f32x4*)(base + off0 + bj * 128 + 4); }
#pragma unroll
        for (int idx = 0; idx < 8; ++idx) {
            const int ai = idx >> 2, m = idx & 3; const size_t off = off0 + (size_t)(ai * 128 + m * 16) * ldc;
            if (idx < 7) {
                const size_t offn = off0 + (size_t)(((idx + 1) >> 2) * 128 + ((idx + 1) & 3) * 16) * ldc;
#pragma unroll
                for (int bj = 0; bj < 2; ++bj) { nxt[bj][0] = *(const f32x4*)(base + offn + bj * 128); nxt[bj][1] = *(const f32x4*)(base + offn + bj * 128 + 4); }
            }
#pragma unroll
            for (int bj = 0; bj < 2; ++bj) { *(f32x4*)(out + off + bj * 128) = cur[bj][0] + acc[ai][bj][m][0]; *(f32x4*)(out + off + bj * 128 + 4) = cur[bj][1] + acc[ai][bj][m][1]; }
#pragma unroll
            for (int bj = 0; bj < 2; ++bj) { cur[bj][0] = nxt[bj][0]; cur[bj][1] = nxt[bj][1]; }
        }
    }
};
struct EpiSwiglu {
    static constexpr bool PERM = true, AFTER_DRAIN = false; bf16_t* O; int ldc;
    __device__ __forceinline__ void operator()(const f32x4 (&acc)[2][2][4][2], const pg8::Unit& u, int wr, int wc, int fr, int fq) const {
#pragma unroll
        for (int ai = 0; ai < 2; ++ai)
#pragma unroll
            for (int m = 0; m < 4; ++m) {
                bf16_t* rp = O + (size_t)(u.pm * 256 + ai * 128 + wr * 64 + m * 16 + fr) * ldc + u.pn * 128 + wc * 32 + fq * 8;
                float r[8];
#pragma unroll
                for (int n = 0; n < 2; ++n) {
                    const f32x4 g = acc[ai][0][m][n], uu = acc[ai][1][m][n];
#pragma unroll
                    for (int j = 0; j < 4; ++j) r[4 * n + j] = g[j] * __builtin_amdgcn_rcpf(1.f + __builtin_amdgcn_exp2f(g[j] * -1.4426950408889634f)) * uu[j];
                }
                *(bf16x8*)rp = pack8(r[0], r[1], r[2], r[3], r[4], r[5], r[6], r[7]);
            }
    }
};

__device__ __forceinline__ void tt_load(const float* s0, const float* s1, const int mode, const int Nsrc, const int kt, const int nt, f32x4 (&v)[4], bool& ok) {
    const int tid = otid(); const int c4 = tid & 31, kr = tid >> 5; const int R = nt * 128 + c4 * 4; const float* s = s0; int col = R; ok = R < Nsrc;
    if (mode != 0) { s = ((R >> 7) & 1) ? s1 : s0; col = (R >> 8) * 128 + (R & 127); ok = true; }
    if (!ok) col = 0;
    const float* sp = s + (size_t)(kt * 64 + kr) * Nsrc + col;
#pragma unroll
    for (int p = 0; p < 4; ++p) v[p] = *(const f32x4*)(sp + (size_t)p * 16 * Nsrc);
}
__device__ __forceinline__ void tt_to_lds(const f32x4 (&v)[4], const bool ok, LAS float* tile) {
    const int tid = otid(); const int c4 = tid & 31, kr = tid >> 5;
#pragma unroll
    for (int p = 0; p < 4; ++p) *(LAS f32x4*)(tile + (p * 16 + kr) * 132 + c4 * 4) = ok ? v[p] : (f32x4){0.f, 0.f, 0.f, 0.f};
}
__device__ __forceinline__ void tt_store(bf16_t* dst, const int K, const int kt, const int nt, LAS float* tile) {
    const int tid = otid(); const int R = tid >> 2, kq = tid & 3; float v[16];
#pragma unroll
    for (int i = 0; i < 16; ++i) v[i] = tile[(kq * 16 + i) * 132 + R];
    bf16_t* d = dst + (size_t)(nt * 128 + R) * K + kt * 64 + kq * 16;
    *(bf16x8*)d = pack8(v[0], v[1], v[2], v[3], v[4], v[5], v[6], v[7]);
    *(bf16x8*)(d + 8) = pack8(v[8], v[9], v[10], v[11], v[12], v[13], v[14], v[15]);
}

__device__ __forceinline__ void rmsnorm_rows(const float* __restrict__ x, const float* __restrict__ g, bf16_t* __restrict__ out) {
    const int lane = otid() & 63, wave = otid() >> 6;
    f32x4 gq[8];
#pragma unroll
    for (int j = 0; j < 8; ++j) gq[j] = *(const f32x4*)(g + (j * 64 + lane) * 4);
    for (int row = (blockIdx.x * 8 + wave) * 2; row < MROWS; row += gridDim.x * 16) {
        f32x4 v[2][8]; float ss[2] = {0.f, 0.f};
#pragma unroll
        for (int q = 0; q < 2; ++q)
#pragma unroll
            for (int j = 0; j < 8; ++j) v[q][j] = *(const f32x4*)(x + (size_t)(row + q) * DM + (j * 64 + lane) * 4);
#pragma unroll
        for (int q = 0; q < 2; ++q) {
#pragma unroll
            for (int j = 0; j < 8; ++j) ss[q] += v[q][j][0] * v[q][j][0] + v[q][j][1] * v[q][j][1] + v[q][j][2] * v[q][j][2] + v[q][j][3] * v[q][j][3];
            ss[q] = wave_sum(ss[q]); const float rs = rsqrtf(ss[q] * (1.f / DM) + 1e-6f);
#pragma unroll
            for (int j = 0; j < 8; ++j) {
                const f32x4 gg = gq[j]; u32x2 w;
                w.x = cvt_pk_bf16(v[q][j][0] * rs * gg[0], v[q][j][1] * rs * gg[1]); w.y = cvt_pk_bf16(v[q][j][2] * rs * gg[2], v[q][j][3] * rs * gg[3]);
                *(u32x2*)(out + (size_t)(row + q) * DM + (j * 64 + lane) * 4) = w;
            }
        }
    }
}

#define TT_DECODE(it_, S0, S1, DST, MODE, KK, NS, KT, NTT) do { \
    constexpr int N0_ = 32 * 44, N1_ = 32 * 16, N2_ = 32 * 88; const int i_ = (it_); \
    if (i_ < N0_) { S0 = S1 = p.in[I_WIN] + (size_t)layer * DM * NIN; DST = (bf16_t*)(p.ws + WS_WIN); MODE = 0; KK = DM; NS = NIN; KT = i_ / 44; NTT = i_ % 44; } \
    else if (i_ < N0_ + N1_) { const int j_ = i_ - N0_; S0 = S1 = p.in[I_WOUT] + (size_t)layer * DM * DM; DST = (bf16_t*)(p.ws + WS_WOUT); MODE = 0; KK = DM; NS = DM; KT = j_ / 16; NTT = j_ % 16; } \
    else if (i_ < N0_ + N1_ + N2_) { const int j_ = i_ - N0_ - N1_; S0 = p.in[I_WG] + (size_t)layer * DM * DFF; S1 = p.in[I_WU] + (size_t)layer * DM * DFF; DST = (bf16_t*)(p.ws + WS_WGU); MODE = 1; KK = DM; NS = DFF; KT = j_ / 88; NTT = j_ % 88; } \
    else { const int j_ = i_ - N0_ - N1_ - N2_; S0 = S1 = p.in[I_WD] + (size_t)layer * DFF * DM; DST = (bf16_t*)(p.ws + WS_WDN); MODE = 0; KK = DFF; NS = DM; KT = j_ / 16; NTT = j_ % 16; } } while (0)
__device__ __forceinline__ void phase_weights(const Params& p, const int layer, LAS unsigned char* lds) {
    LAS float* tile = (LAS float*)lds;
    constexpr int NT = 32 * 44;
    int Gs = gridDim.x; asm volatile("" : "+s"(Gs));
    int it = blockIdx.x; if (it >= NT) return;
    f32x4 v[4]; bool ok;
    { const float* s0; const float* s1; bf16_t* dst; int mode, K, Ns, kt, nt; TT_DECODE(it, s0, s1, dst, mode, K, Ns, kt, nt); tt_load(s0, s1, mode, Ns, kt, nt, v, ok); (void)dst; (void)K; }
    for (;;) {
        tt_to_lds(v, ok, tile);
        __syncthreads();
        const int itn = it + Gs; const bool more = itn < NT;
        if (more) { const float* s0; const float* s1; bf16_t* dst; int mode, K, Ns, kt, nt; TT_DECODE(itn, s0, s1, dst, mode, K, Ns, kt, nt); tt_load(s0, s1, mode, Ns, kt, nt, v, ok); (void)dst; (void)K; }
        { const float* s0; const float* s1; bf16_t* dst; int mode, K, Ns, kt, nt; TT_DECODE(it, s0, s1, dst, mode, K, Ns, kt, nt); tt_store(dst, K, kt, nt, tile); (void)s0; (void)s1; (void)mode; (void)Ns; }
        __syncthreads();
        if (!more) break;
        it = itn;
    }
}
__device__ __forceinline__ void weights_queue(const Params& p, const int layer, LAS unsigned char* lds, unsigned* ctr) {
    LAS float* tile = (LAS float*)lds; volatile LAS int* slot = (volatile LAS int*)(lds + 64 * 132 * 4);
    constexpr int T0 = 32 * 44, NT = 32 * 44 + 32 * 16 + 32 * 88 + 88 * 16, CH = 8;
    for (;;) {
        if (otid() == 0) slot[0] = T0 + CH * (int)__hip_atomic_fetch_add(ctr, 1u, __ATOMIC_RELAXED, __HIP_MEMORY_SCOPE_AGENT);
        __syncthreads();
        const int base = slot[0];
        if (base >= NT) break;
        const int end = base + CH < NT ? base + CH : NT;
        f32x4 v[4]; bool ok;
        { const float* s0; const float* s1; bf16_t* dst; int mode, K, Ns, kt, nt; TT_DECODE(base, s0, s1, dst, mode, K, Ns, kt, nt); tt_load(s0, s1, mode, Ns, kt, nt, v, ok); (void)dst; (void)K; }
        for (int it = base; it < end; ++it) {
            tt_to_lds(v, ok, tile);
            __syncthreads();
            if (it + 1 < end) { const float* s0; const float* s1; bf16_t* dst; int mode, K, Ns, kt, nt; TT_DECODE(it + 1, s0, s1, dst, mode, K, Ns, kt, nt); tt_load(s0, s1, mode, Ns, kt, nt, v, ok); (void)dst; (void)K; }
            { const float* s0; const float* s1; bf16_t* dst; int mode, K, Ns, kt, nt; TT_DECODE(it, s0, s1, dst, mode, K, Ns, kt, nt); tt_store(dst, K, kt, nt, tile); (void)s0; (void)s1; (void)mode; (void)Ns; }
            __syncthreads();
        }
    }
    __syncthreads();
}
__device__ __forceinline__ void store_vt16(bf16_t* dst, const float (&v)[16]) {
    u32x4 w0, w1;
    w0.x = cvt_pk_bf16(v[0], v[1]); w0.y = cvt_pk_bf16(v[2], v[3]); w0.z = cvt_pk_bf16(v[8], v[9]); w0.w = cvt_pk_bf16(v[10], v[11]);
    w1.x = cvt_pk_bf16(v[4], v[5]); w1.y = cvt_pk_bf16(v[6], v[7]); w1.z = cvt_pk_bf16(v[12], v[13]); w1.w = cvt_pk_bf16(v[14], v[15]);
    *(u32x4*)dst = w0; *(u32x4*)(dst + 8) = w1;
}

__device__ __forceinline__ void token_prep_unit(const Params& p, const int layer, const int u) {
    const int lane = otid() & 63, wave = otid() >> 6;
    const int row0 = u * 64 + (wave & 3) * 16; const int b = row0 >> 11, t16 = (row0 & 2047) >> 4;
    const bf16_t* proj = (const bf16_t*)(p.ws + WS_PROJ); float* mix = (float*)(p.ws + WS_MIX);
    if ((wave >> 2) == 0) {
        bf16_t* QN = (bf16_t*)(p.ws + WS_QN); bf16_t* KS = (bf16_t*)(p.ws + WS_KS); bf16_t* KW = (bf16_t*)(p.ws + WS_KW);
        const int d0 = (lane & 7) * 8;
        const f32x4 qg0 = *(const f32x4*)(p.in[I_QG] + layer * 64 + d0), qg1 = *(const f32x4*)(p.in[I_QG] + layer * 64 + d0 + 4);
        const f32x4 kg0 = *(const f32x4*)(p.in[I_KG] + layer * 64 + d0), kg1 = *(const f32x4*)(p.in[I_KG] + layer * 64 + d0 + 4);
        const float* cw = p.in[I_CONV] + (size_t)layer * 3 * 512 + lane * 8;
        const f32x4 c0a = *(const f32x4*)(cw), c0b = *(const f32x4*)(cw + 4), c1a = *(const f32x4*)(cw + 512), c1b = *(const f32x4*)(cw + 516), c2a = *(const f32x4*)(cw + 1024), c2b = *(const f32x4*)(cw + 1028);
        f32x4 z1a, z1b, z2a, z2b;
        if ((row0 & 2047) == 0) { z1a = z1b = z2a = z2b = (f32x4){0.f, 0.f, 0.f, 0.f}; }
        else {
            const bf16_t* P1 = proj + (size_t)(row0 - 1) * NPJ + lane * 8; const bf16_t* P2 = proj + (size_t)(row0 - 2) * NPJ + lane * 8;
            const u32x4 r1c = *(const u32x4*)(P1 + C_CG), r1h = *(const u32x4*)(P1 + C_BH), r2c = *(const u32x4*)(P2 + C_CG), r2h = *(const u32x4*)(P2 + C_BH);
            { const F8 c1 = up8(r1c), h1 = up8(r1h); z1a = c1.a * h1.a; z1b = c1.b * h1.b; }
            { const F8 c2 = up8(r2c), h2 = up8(r2h); z2a = c2.a * h2.a; z2b = c2.b * h2.b; }
        }
#pragma unroll 1
        for (int i0 = 0; i0 < 16; i0 += 4) {
            u32x4 rq[4], rk[4], rcg[4], rbh[4], rbg[4];
            const int l5 = lane & 31, sel = l5 >> 4, cc = (l5 & 15) * 8;
#pragma unroll
            for (int j = 0; j < 4; ++j) {
                const bf16_t* P = proj + (size_t)(row0 + i0 + j) * NPJ;
                rq[j] = *(const u32x4*)(P + lane * 8); rk[j] = *(const u32x4*)(P + (sel ? C_KW : C_KS) + cc);
                rcg[j] = *(const u32x4*)(P + lane * 8 + C_CG); rbh[j] = *(const u32x4*)(P + lane * 8 + C_BH); rbg[j] = *(const u32x4*)(P + lane * 8 + C_BG);
            }
#pragma unroll
            for (int j = 0; j < 4; ++j) {
                const int row = row0 + i0 + j;
                {
                    const F8 q8 = up8(rq[j]); const f32x4 a = q8.a, c = q8.b;
                    float ss = a[0] * a[0] + a[1] * a[1] + a[2] * a[2] + a[3] * a[3] + c[0] * c[0] + c[1] * c[1] + c[2] * c[2] + c[3] * c[3];
                    ss += __shfl_xor(ss, 1); ss += __shfl_xor(ss, 2); ss += __shfl_xor(ss, 4);
                    const float r = rsqrtf(ss * (1.f / 64.f) + 1e-6f); constexpr float QSC = 0.125f * 1.4426950408889634f;
                    *(bf16x8*)(QN + (size_t)row * 512 + lane * 8) = pack8(a[0] * r * qg0[0] * QSC, a[1] * r * qg0[1] * QSC, a[2] * r * qg0[2] * QSC, a[3] * r * qg0[3] * QSC,
                                                                           c[0] * r * qg1[0] * QSC, c[1] * r * qg1[1] * QSC, c[2] * r * qg1[2] * QSC, c[3] * r * qg1[3] * QSC);
                }
                {
                    const F8 k8 = up8(rk[j]); const f32x4 a = k8.a, c = k8.b;
                    float ss = a[0] * a[0] + a[1] * a[1] + a[2] * a[2] + a[3] * a[3] + c[0] * c[0] + c[1] * c[1] + c[2] * c[2] + c[3] * c[3];
                    ss += __shfl_xor(ss, 1); ss += __shfl_xor(ss, 2); ss += __shfl_xor(ss, 4);
                    const float r = rsqrtf(ss * (1.f / 64.f) + 1e-6f);
                    const int tk = row & 2047, gk = cc >> 6, dk = cc & 63;
                    if (lane < 32) *(bf16x8*)((sel ? KW : KS) + ((size_t)((b * 2 + gk) * 64 + (tk >> 5)) * 2048 + (size_t)((dk >> 4) * 64 + ((dk >> 3) & 1) * 32 + (tk & 31)) * 8)) =
                        pack8(a[0] * r * kg0[0], a[1] * r * kg0[1], a[2] * r * kg0[2], a[3] * r * kg0[3], c[0] * r * kg1[0], c[1] * r * kg1[1], c[2] * r * kg1[2], c[3] * r * kg1[3]);
                }
                {
                    const F8 cg8 = up8(rcg[j]), bh8 = up8(rbh[j]), bg8 = up8(rbg[j]);
                    const f32x4 za = cg8.a * bh8.a, zb = cg8.b * bh8.b;
                    const f32x4 ya = c0a * z2a + c1a * z1a + c2a * za, yb = c0b * z2b + c1b * z1b + c2b * zb;
                    *(f32x4*)(mix + (size_t)row * DM + 512 + lane * 8) = bg8.a * ya;
                    *(f32x4*)(mix + (size_t)row * DM + 512 + lane * 8 + 4) = bg8.b * yb;
                    z2a = z1a; z2b = z1b; z1a = za; z1b = zb;
                }
            }
        }
        {
            float v[4][16];
#pragma unroll
            for (int sel = 0; sel < 4; ++sel) {
                const int col = (sel < 2 ? C_VS : C_VW) + (sel & 1) * 64 + lane;
#pragma unroll
                for (int i = 0; i < 16; ++i) v[sel][i] = bf2f(proj[(size_t)(row0 + i) * NPJ + col]);
            }
#pragma unroll
            for (int sel = 0; sel < 4; ++sel)
                store_vt16((bf16_t*)(p.ws + (sel < 2 ? WS_VST : WS_VWT)) + ((size_t)((b * 2 + (sel & 1)) * 128 + t16) * 64 + lane) * 16, v[sel]);
        }
    } else {
        bf16_t* DQ = (bf16_t*)(p.ws + WS_DQ); bf16_t* DK = (bf16_t*)(p.ws + WS_DK); bf16_t* DVT = (bf16_t*)(p.ws + WS_DVT);
#pragma unroll 1
        for (int i0 = 0; i0 < 16; i0 += 8) {
            u32x4 rq[8], rk[8];
#pragma unroll
            for (int j = 0; j < 8; ++j) { const bf16_t* P = proj + (size_t)(row0 + i0 + j) * NPJ + lane * 8; rq[j] = *(const u32x4*)(P + C_DQ); rk[j] = *(const u32x4*)(P + C_DK); }
#pragma unroll
            for (int j = 0; j < 8; ++j) {
                const int row = row0 + i0 + j; const F8 q8 = up8(rq[j]); const f32x4 qa = q8.a, qb = q8.b;
                *(bf16x8*)(DQ + (size_t)row * 512 + lane * 8) = pack8(qa[0] * 0.125f, qa[1] * 0.125f, qa[2] * 0.125f, qa[3] * 0.125f, qb[0] * 0.125f, qb[1] * 0.125f, qb[2] * 0.125f, qb[3] * 0.125f);
                const int tk = row & 2047, hk = lane >> 3, dk = (lane & 7) * 8;
                *(u32x4*)(DK + ((size_t)((b * 8 + hk) * 64 + (tk >> 5)) * 2048 + (size_t)((dk >> 4) * 64 + ((dk >> 3) & 1) * 32 + (tk & 31)) * 8)) = rk[j];
            }
        }
#pragma unroll 1
        for (int h0 = 0; h0 < 8; h0 += 4) {
            float v[4][16];
#pragma unroll
            for (int hh = 0; hh < 4; ++hh)
#pragma unroll
                for (int i = 0; i < 16; ++i) v[hh][i] = bf2f(proj[(size_t)(row0 + i) * NPJ + C_DV + (h0 + hh) * 64 + lane]);
#pragma unroll
            for (int hh = 0; hh < 4; ++hh) store_vt16(DVT + ((size_t)((b * 8 + h0 + hh) * 128 + t16) * 64 + lane) * 16, v[hh]);
        }
    }
}

__device__ __forceinline__ void sgu_unit(const Params& p, const int layer, const int u, LAS unsigned char* lds) {
    const int lane = otid() & 63, wave = otid() >> 6;
    const int hh = u & 1, row0 = (u >> 1) * 128;
    const bf16_t* proj = (const bf16_t*)(p.ws + WS_PROJ); float* mix = (float*)(p.ws + WS_MIX);
    LAS bf16_t* vT = (LAS bf16_t*)lds;
    u32x4 rv[16];
#pragma unroll
    for (int i = 0; i < 16; ++i) rv[i] = *(const u32x4*)(proj + (size_t)(row0 + wave * 16 + i) * NPJ + C_CV + lane * 8);
#pragma unroll
    for (int i = 0; i < 16; ++i) {
        const int tk = wave * 16 + i;
        const F8 v8 = up8(rv[i]); const f32x4 a = v8.a, c = v8.b; float gv[8];
#pragma unroll
        for (int j = 0; j < 4; ++j) { gv[j] = gelu_tanh(a[j]); gv[4 + j] = gelu_tanh(c[j]); }
        float s = 0.f;
#pragma unroll
        for (int j = 0; j < 8; ++j) s += gv[j];
        s = wave_sum(s); const float mu = s * (1.f / 512.f); float q = 0.f;
#pragma unroll
        for (int j = 0; j < 8; ++j) { gv[j] -= mu; q += gv[j] * gv[j]; }
        q = wave_sum(q); const float rs = rsqrtf(q * (1.f / 512.f) + 1e-5f);
        if ((lane >> 5) == hh) {
            const int chl = (lane & 31) * 8;
#pragma unroll
            for (int j = 0; j < 8; ++j) vT[(chl + j) * 136 + tk] = bf1(gv[j] * rs);
        }
    }
    __syncthreads();
    const int hl = wave & 3, h = hh * 4 + hl, ph = wave >> 2, ql = lane & 31, hf = lane >> 5;
    const float* W = p.in[I_SGW] + (size_t)(layer * 8 + h) * 128 * 128;
    f32x16 acc[2][2];
#pragma unroll
    for (int a = 0; a < 2; ++a)
#pragma unroll
        for (int c = 0; c < 2; ++c)
#pragma unroll
            for (int r = 0; r < 16; ++r) acc[a][c][r] = 0.f;
#pragma unroll
    for (int ptl = 0; ptl < 2; ++ptl) {
        const int pt = ph * 2 + ptl, prow = pt * 32 + ql;
#pragma unroll 2
        for (int kc = 0; kc <= 2 * pt + 1; ++kc) {
            const int q0 = kc * 16 + hf * 8; const float* wp = W + (size_t)prow * 128 + q0;
            const f32x4 w0 = *(const f32x4*)(wp), w1 = *(const f32x4*)(wp + 4);
            const bf16x8 A = pack8(q0 + 0 <= prow ? w0[0] : 0.f, q0 + 1 <= prow ? w0[1] : 0.f, q0 + 2 <= prow ? w0[2] : 0.f, q0 + 3 <= prow ? w0[3] : 0.f,
                                   q0 + 4 <= prow ? w1[0] : 0.f, q0 + 5 <= prow ? w1[1] : 0.f, q0 + 6 <= prow ? w1[2] : 0.f, q0 + 7 <= prow ? w1[3] : 0.f);
#pragma unroll
            for (int et = 0; et < 2; ++et) {
                const bf16x8 Bv = *(const LAS bf16x8*)(vT + (hl * 64 + et * 32 + ql) * 136 + kc * 16 + hf * 8);
                acc[ptl][et] = mfma32(A, Bv, acc[ptl][et]);
            }
        }
    }
    const float* sb = p.in[I_SGB] + (size_t)(layer * 8 + h) * 128;
#pragma unroll
    for (int ptl = 0; ptl < 2; ++ptl) {
        bf16_t uraw[2][16];
#pragma unroll
        for (int et = 0; et < 2; ++et)
#pragma unroll
            for (int r = 0; r < 16; ++r) uraw[et][r] = proj[(size_t)(row0 + (ph * 2 + ptl) * 32 + (r & 3) + 8 * (r >> 2) + 4 * hf) * NPJ + C_CU + h * 64 + et * 32 + ql];
        float sbv[16];
#pragma unroll
        for (int r = 0; r < 16; ++r) sbv[r] = sb[(ph * 2 + ptl) * 32 + (r & 3) + 8 * (r >> 2) + 4 * hf];
#pragma unroll
        for (int et = 0; et < 2; ++et)
#pragma unroll
            for (int r = 0; r < 16; ++r) {
                const int pr = (ph * 2 + ptl) * 32 + (r & 3) + 8 * (r >> 2) + 4 * hf; const int col = h * 64 + et * 32 + ql;
                mix[(size_t)(row0 + pr) * DM + 1024 + col] = gelu_tanh(bf2f(uraw[et][r])) * (acc[ptl][et][r] + sbv[r]);
            }
    }
    __syncthreads();
}

__device__ __forceinline__ void compress_unit(const Params& p, const int layer, const int u, LAS unsigned char* lds) {
    const int tid = otid(), lane = tid & 63, wave = tid >> 6;
    const int combo = u >> 3, b = combo >> 2, g = (combo >> 1) & 1, kv = combo & 1, n0 = (u & 7) * 16;
    const bf16_t* proj = (const bf16_t*)(p.ws + WS_PROJ);
    LAS float* red = (LAS float*)lds; LAS float* hid = red + 8 * 17 * 64;
    const int colbase = (kv ? C_VC : C_KC) + g * 64;
    const float* W1 = p.in[I_CW1] + (size_t)(layer * 2 + kv) * 2048 * 64;
    const float* pos = p.in[I_CPOS] + (size_t)(layer * 2 + kv) * 2048;
    const int ql = lane & 31, hf = lane >> 5;
    f32x16 acc[2];
#pragma unroll
    for (int ct = 0; ct < 2; ++ct)
#pragma unroll
        for (int r = 0; r < 16; ++r) acc[ct][r] = 0.f;
#pragma unroll 2
    for (int st = 0; st < 16; ++st) {
        const int l = wave * 4 + (st >> 2), d0 = (st & 3) * 16 + hf * 8;
        bf16x8 A = {0, 0, 0, 0, 0, 0, 0, 0};
        if (ql < 16) { const int t = 16 * (n0 + ql) + l; if (t < T) A = *(const bf16x8*)(proj + (size_t)(b * T + t) * NPJ + colbase + d0); }
        else if (ql == 16) { const f32x4 p0 = *(const f32x4*)(pos + l * 64 + d0), p1 = *(const f32x4*)(pos + l * 64 + d0 + 4); A = pack8(p0[0], p0[1], p0[2], p0[3], p1[0], p1[1], p1[2], p1[3]); }
        const float* wp = W1 + (size_t)(l * 64 + d0) * 64 + ql;
#pragma unroll
        for (int ct = 0; ct < 2; ++ct) {
            float w[8];
#pragma unroll
            for (int j = 0; j < 8; ++j) w[j] = wp[j * 64 + ct * 32];
            acc[ct] = mfma32(A, pack8(w[0], w[1], w[2], w[3], w[4], w[5], w[6], w[7]), acc[ct]);
        }
    }
#pragma unroll
    for (int ct = 0; ct < 2; ++ct)
#pragma unroll
        for (int r = 0; r < 16; ++r) {
            const int row = (r & 3) + 8 * (r >> 2) + 4 * hf;
            if (row <= 16) red[(wave * 17 + row) * 64 + ct * 32 + ql] = acc[ct][r];
        }
    __syncthreads();
    for (int o = tid; o < 1024; o += 512) {
        const int r = o >> 6, cc = o & 63; float s = 0.f;
#pragma unroll
        for (int k = 0; k < 8; ++k) s += red[(k * 17 + r) * 64 + cc] + red[(k * 17 + 16) * 64 + cc];
        hid[o] = gelu_tanh(s);
    }
    __syncthreads();
    const float* W2 = p.in[I_CW2] + (size_t)(layer * 2 + kv) * 64 * 64;
    float w2c[64];
#pragma unroll
    for (int k = 0; k < 64; ++k) w2c[k] = W2[k * 64 + lane];
#pragma unroll
    for (int i = 0; i < 2; ++i) {
        const int r = wave + 8 * i; float s = 0.f;
#pragma unroll
        for (int k = 0; k < 64; k += 4) { const f32x4 hv = *(const LAS f32x4*)(hid + r * 64 + k); s += hv[0] * w2c[k] + hv[1] * w2c[k + 1] + hv[2] * w2c[k + 2] + hv[3] * w2c[k + 3]; }
        const int n = n0 + r;
        if (kv == 0) {
            const float ss = wave_sum(s * s); const float o = s * rsqrtf(ss * (1.f / 64.f) + 1e-6f) * p.in[I_KG][layer * 64 + lane];
            ((bf16_t*)(p.ws + WS_KCN))[(size_t)((b * 2 + g) * 4 + (n >> 5)) * 2048 + (size_t)((lane >> 4) * 64 + ((lane >> 3) & 1) * 32 + (n & 31)) * 8 + (lane & 7)] = bf1(o);
        } else {
            ((bf16_t*)(p.ws + WS_VCT))[(((size_t)(b * 2 + g) * 8 + (n >> 4)) * 64 + lane) * 16 + slot16(n & 15)] = bf1(s);
        }
    }
    __syncthreads();
}
#define PRIO_HI() __builtin_amdgcn_s_setprio(1)
#define PRIO_LO() __builtin_amdgcn_s_setprio(0)
__device__ __forceinline__ f32x16 st_tile(const bf16_t* __restrict__ kp  , const int ldk, const bf16x8 (&qf)[4], const int ql, const int hf) {
    f32x16 s;
#pragma unroll
    for (int r = 0; r < 16; ++r) s[r] = 0.f;
#pragma unroll
    for (int kk = 0; kk < 4; ++kk) { const bf16x8 kf = *(const bf16x8*)(kp + (size_t)ql * ldk + kk * 16 + hf * 8); s = mfma32(kf, qf[kk], s); }
    return s;
}
__device__ __forceinline__ void pv_tile(const bf16_t* __restrict__ vt, const f32x16& pm, f32x16 (&o)[2], const int ql, const int hf) {
#pragma unroll
    for (int kc = 0; kc < 2; ++kc) {
        const bf16x8 pb = pack8(pm[8 * kc + 0], pm[8 * kc + 1], pm[8 * kc + 2], pm[8 * kc + 3], pm[8 * kc + 4], pm[8 * kc + 5], pm[8 * kc + 6], pm[8 * kc + 7]);
#pragma unroll
        for (int dt = 0; dt < 2; ++dt) { const bf16x8 vf = *(const bf16x8*)(vt + ((size_t)(kc * 64 + dt * 32 + ql)) * 16 + hf * 8); o[dt] = mfma32(vf, pb, o[dt]); }
    }
}
__device__ __forceinline__ void osm_tile(f32x16& s, float& m, float& l, f32x16 (&o)[2], const bf16_t* __restrict__ vt, const int ql, const int hf) {
    float mx = s[0];
#pragma unroll
    for (int r = 1; r < 16; ++r) mx = fmaxf(mx, s[r]);
    mx = fmaxf(mx, __shfl_xor(mx, 32));
    const float mn = fmaxf(m, mx); const float alpha = __expf(m - mn); float ps = 0.f;
#pragma unroll
    for (int r = 0; r < 16; ++r) { const float pv = s[r] > -1e29f ? __expf(s[r] - mn) : 0.f; s[r] = pv; ps += pv; }
    l = l * alpha + ps; m = mn;
#pragma unroll
    for (int dt = 0; dt < 2; ++dt)
#pragma unroll
        for (int r = 0; r < 16; ++r) o[dt][r] *= alpha;
    pv_tile(vt, s, o, ql, hf);
}

#define LOADK4L(dst, kptr, ld) do { _Pragma("unroll") for (int kk_ = 0; kk_ < 4; ++kk_) dst[kk_] = *(const bf16x8*)((kptr) + (size_t)ql * (ld) + kk_ * 16 + hf * 8); } while (0)
#define LOADK4F(dst, tptr) do { _Pragma("unroll") for (int kk_ = 0; kk_ < 4; ++kk_) dst[kk_] = *(const bf16x8*)((tptr) + (size_t)(kk_ * 64 + hf * 32 + ql) * 8); } while (0)
#define PIN4(a) do { _Pragma("unroll") for (int i_ = 0; i_ < 4; ++i_) asm volatile("" : "+v"(a[i_])); } while (0)
#define COPY4(d, s_) do { _Pragma("unroll") for (int i_ = 0; i_ < 4; ++i_) d[i_] = s_[i_]; } while (0)
#define LOADV4(dst, vptr) do { _Pragma("unroll") for (int i_ = 0; i_ < 4; ++i_) dst[i_] = *(const bf16x8*)((vptr) + (size_t)(((i_ >> 1) * 64 + (i_ & 1) * 32 + ql) * 16 + hf * 8)); } while (0)
constexpr int TS_N = 2080, TW_N = 576, TBL_H = TS_N + TW_N, TBL_ALL = 8 * TBL_H;
constexpr float LOG2E = 1.4426950408889634f;
__device__ __forceinline__ float ex2(float x) { return __builtin_amdgcn_exp2f(x); }

__device__ __forceinline__ void cmp_unit(const Params& p, const int un, const LAS float* tbl, LAS float* impL  , LAS float* impT  ) {
    const int lane = otid() & 63, ql = lane & 31, hf = lane >> 5;
    const int bg = un & 15, qt = 63 - (un >> 4), b = bg >> 1, g = bg & 1, q0 = qt * 32, tq = q0 + ql; const size_t rowq = (size_t)b * T + tq;
    const bf16_t* proj = (const bf16_t*)(p.ws + WS_PROJ); float* mix = (float*)(p.ws + WS_MIX);
    const bf16_t* QN = (const bf16_t*)(p.ws + WS_QN);
    const bf16_t* Kc = (const bf16_t*)(p.ws + WS_KCN) + (size_t)(b * 2 + g) * 4 * 2048;
    const bf16_t* Vc = (const bf16_t*)(p.ws + WS_VCT) + (size_t)(b * 2 + g) * 8 * 64 * 16;
#pragma unroll
    for (int a = 0; a < 16; ++a) impL[a * 64 + lane] = 0.f;
    bf16_t graw[4];
#pragma unroll
    for (int r4 = 0; r4 < 4; ++r4) graw[r4] = proj[rowq * NPJ + C_AG + (g * 4 + r4) * 3 + 0];
    bf16x8 kA[4], kB[4], vA[4], vB[4];
    LOADK4F(kA, Kc); LOADK4F(kB, Kc + 2048); LOADV4(vA, Vc); LOADV4(vB, Vc + (size_t)2 * 1024);
    PIN4(kA); PIN4(kB); PIN4(vA); PIN4(vB);
    for (int r4 = 0; r4 < 4; ++r4) {
        const int hq = g * 4 + r4; const LAS float* bl = tbl + hq * TBL_H;
        bf16x8 qf[4];
#pragma unroll
        for (int kk = 0; kk < 4; ++kk) qf[kk] = *(const bf16x8*)(QN + rowq * 512 + hq * 64 + kk * 16 + hf * 8);
        float l = 0.f;
        f32x16 o[2];
#pragma unroll
        for (int dt = 0; dt < 2; ++dt)
#pragma unroll
            for (int r = 0; r < 16; ++r) o[dt][r] = 0.f;
        float prev_tile = 0.f;
#pragma unroll 1
        for (int pi = 0; pi < 2; ++pi) {
#pragma unroll
            for (int e = 0; e < 2; ++e) {
                const int kt = 2 * pi + e, ktn = (kt + 2) & 3;
                f32x16 s;
#pragma unroll
                for (int r = 0; r < 16; ++r) s[r] = 0.f;
                if (e == 0) {
                    PRIO_HI();
#pragma unroll
                    for (int kk = 0; kk < 4; ++kk) s = mfma32(kA[kk], qf[kk], s);
                    PRIO_LO();
                    LOADK4F(kA, Kc + (size_t)ktn * 2048);
                } else {
                    PRIO_HI();
#pragma unroll
                    for (int kk = 0; kk < 4; ++kk) s = mfma32(kB[kk], qf[kk], s);
                    PRIO_LO();
                    LOADK4F(kB, Kc + (size_t)ktn * 2048);
                }
                float ps = 0.f;
#pragma unroll
                for (int r = 0; r < 16; ++r) {
                    const int di = tq + 1 - 16 * (kt * 32 + (r & 3) + 8 * (r >> 2) + 4 * hf);
                    s[r] = ex2(s[r] + bl[di > 0 ? di : 0]); ps += s[r];
                }
                l += ps;
                float oth[4];
#pragma unroll
                for (int rg = 0; rg < 4; ++rg) oth[rg] = __shfl_xor(s[4 * rg + 3], 32);
#pragma unroll
                for (int rg = 0; rg < 4; ++rg) {
                    const float prev = hf ? oth[rg] : (rg > 0 ? oth[rg > 0 ? rg - 1 : 0] : prev_tile);
                    impT[(kt * 4 + rg) * 64 + lane] = s[4 * rg] + s[4 * rg + 1] + s[4 * rg + 2] + 0.5f * s[4 * rg + 3] + 0.5f * prev;
                }
                prev_tile = oth[3];
#pragma unroll
                for (int kc = 0; kc < 2; ++kc) {
                    const bf16x8 pb = pack8(s[8 * kc + 0], s[8 * kc + 1], s[8 * kc + 2], s[8 * kc + 3], s[8 * kc + 4], s[8 * kc + 5], s[8 * kc + 6], s[8 * kc + 7]);
#pragma unroll
                    for (int dt = 0; dt < 2; ++dt) o[dt] = mfma32(e == 0 ? vA[kc * 2 + dt] : vB[kc * 2 + dt], pb, o[dt]);
                }
                if (e == 0) LOADV4(vA, Vc + (size_t)(ktn * 2) * 1024); else LOADV4(vB, Vc + (size_t)(ktn * 2) * 1024);
            }
        }
        l += __shfl_xor(l, 32);
        const float inv = l > 0.f ? 1.f / l : 0.f;
#pragma unroll
        for (int a = 0; a < 16; ++a) impL[a * 64 + lane] += impT[a * 64 + lane] * inv;
#pragma unroll
        for (int dt = 0; dt < 2; ++dt)
#pragma unroll
            for (int r = 0; r < 16; ++r) o[dt][r] *= inv;
        const float g0 = sigmoidf_(bf2f(graw[r4]));
#pragma unroll
        for (int dt = 0; dt < 2; ++dt)
#pragma unroll
            for (int rg = 0; rg < 4; ++rg)
                *(f32x4*)(mix + rowq * DM + hq * 64 + dt * 32 + 8 * rg + 4 * hf) = (f32x4){o[dt][4 * rg] * g0, o[dt][4 * rg + 1] * g0, o[dt][4 * rg + 2] * g0, o[dt][4 * rg + 3] * g0};
    }
    {
        const int cur = tq >> 6; float own[16], oth[16];
#pragma unroll
        for (int a = 0; a < 16; ++a) {
            const int j = 2 * a + hf; const bool forced = (j == 0) || (j == cur) || (j == cur - 1);
            own[a] = j <= cur ? impL[a * 64 + lane] + (forced ? 1000.f : 0.f) : -1e30f;
        }
#pragma unroll
        for (int a = 0; a < 16; ++a) { oth[a] = __shfl_xor(own[a], 32); impL[a * 64 + lane] = own[a]; }
        unsigned bits = 0u;
#pragma unroll 1
        for (int a = 0; a < 16; ++a) {
            int rank = 0; const float y = impL[a * 64 + lane]; const int ao = hf ? a + 1 : a;
#pragma unroll
            for (int c = 0; c < 16; ++c) {
                rank += (own[c] > y || (own[c] == y && c < a)) ? 1 : 0;
                rank += (oth[c] > y || (oth[c] == y && c < ao)) ? 1 : 0;
            }
            const int j = 2 * a + hf;
            if (j <= cur && rank < 16) bits |= 1u << j;
        }
        const unsigned msk = bits | (unsigned)__shfl_xor((int)bits, 32);
        if (hf == 0) ((unsigned*)(p.ws + WS_MSK))[(size_t)(b * 2 + g) * T + tq] = msk;
    }
}

__device__ __forceinline__ void osm3_tile(f32x16& s, float& l, f32x16 (&o)[2], const bf16x8 (&vf)[4]) {
    float ps = 0.f;
#pragma unroll
    for (int r = 0; r < 16; ++r) { s[r] = ex2(s[r]); ps += s[r]; }
    l += ps;
    const bf16x8 pb0 = pack8(s[0], s[1], s[2], s[3], s[4], s[5], s[6], s[7]), pb1 = pack8(s[8], s[9], s[10], s[11], s[12], s[13], s[14], s[15]);
    PRIO_HI();
    o[0] = mfma32(vf[0], pb0, o[0]); o[1] = mfma32(vf[1], pb0, o[1]); o[0] = mfma32(vf[2], pb1, o[0]); o[1] = mfma32(vf[3], pb1, o[1]);
    PRIO_LO();
}
__device__ __forceinline__ void slc_next(unsigned& U, int& j, int& sub, const int q0, const bool first) {
    if (!first) { if (j >= 32) return; if (sub == 0 && j * 64 + 32 <= q0 + 31) { sub = 1; return; } }
    sub = 0; if (U) { j = __builtin_ctz(U); U &= U - 1; } else j = 32;
}
__device__ __forceinline__ void ws_unit(const Params& p, const int b, const int hq, const int qt, const LAS float* tbl) {
    const int lane = otid() & 63, ql = lane & 31, hf = lane >> 5;
    const int g = hq >> 2, q0 = qt * 32, tq = q0 + ql; const size_t rowq = (size_t)b * T + tq;
    const bf16_t* proj = (const bf16_t*)(p.ws + WS_PROJ); float* mix = (float*)(p.ws + WS_MIX);
    const bf16_t* KSb = (const bf16_t*)(p.ws + WS_KS) + (size_t)(b * 2 + g) * 64 * 2048;
    const bf16_t* KWb = (const bf16_t*)(p.ws + WS_KW) + (size_t)(b * 2 + g) * 64 * 2048;
    const bf16_t* VSb = (const bf16_t*)(p.ws + WS_VST) + (size_t)(b * 2 + g) * 128 * 64 * 16;
    const bf16_t* VWb = (const bf16_t*)(p.ws + WS_VWT) + (size_t)(b * 2 + g) * 128 * 64 * 16;
    const LAS float* tS = tbl + hq * TBL_H; const LAS float* tW = tS + TS_N;
    const unsigned msk = ((const unsigned*)(p.ws + WS_MSK))[(size_t)(b * 2 + g) * T + tq];
    bf16x8 qf[4];
#pragma unroll
    for (int kk = 0; kk < 4; ++kk) qf[kk] = *(const bf16x8*)((const bf16_t*)(p.ws + WS_QN) + rowq * 512 + hq * 64 + kk * 16 + hf * 8);
    const float graw_s = bf2f(proj[rowq * NPJ + C_AG + hq * 3 + 1]), graw_w = bf2f(proj[rowq * NPJ + C_AG + hq * 3 + 2]);
    f32x16 o[2]; float l = 0.f;
#pragma unroll
    for (int dt = 0; dt < 2; ++dt)
#pragma unroll
        for (int r = 0; r < 16; ++r) o[dt][r] = 0.f;
    bf16x8 kA[4], kB[4], vA[4], vB[4];
    {
        const int ktlo = (q0 > 511 ? q0 - 511 : 0) >> 5;
        LOADK4F(kA, KWb + (size_t)ktlo * 2048); LOADV4(vA, VWb + (size_t)(ktlo * 2) * 1024);
        { const int t1 = ktlo < qt ? ktlo + 1 : qt; LOADK4F(kB, KWb + (size_t)t1 * 2048); LOADV4(vB, VWb + (size_t)(t1 * 2) * 1024); }
        PIN4(kA); PIN4(vA); PIN4(kB); PIN4(vB);
        for (int kt = ktlo; kt <= qt; kt += 2) {
            const int ka = kt + 2 < qt ? kt + 2 : qt, kb = kt + 3 < qt ? kt + 3 : qt;
            {
                f32x16 s;
#pragma unroll
                for (int r = 0; r < 16; ++r) s[r] = 0.f;
                PRIO_HI();
#pragma unroll
                for (int kk = 0; kk < 4; ++kk) s = mfma32(kA[kk], qf[kk], s);
                PRIO_LO();
                LOADK4F(kA, KWb + (size_t)ka * 2048);
                const LAS float* tb = tW + (tq - kt * 32 + 5 - 4 * hf);
#pragma unroll
                for (int r = 0; r < 16; ++r) s[r] += tb[27 - (r & 3) - 8 * (r >> 2)];
                osm3_tile(s, l, o, vA);
                LOADV4(vA, VWb + (size_t)(ka * 2) * 1024);
            }
            {
                const bool real = kt + 1 <= qt;
                f32x16 s;
#pragma unroll
                for (int r = 0; r < 16; ++r) s[r] = 0.f;
                PRIO_HI();
#pragma unroll
                for (int kk = 0; kk < 4; ++kk) s = mfma32(kB[kk], qf[kk], s);
                PRIO_LO();
                LOADK4F(kB, KWb + (size_t)kb * 2048);
                const LAS float* tb = real ? tW + (tq - (kt + 1) * 32 + 5 - 4 * hf) : tS;
#pragma unroll
                for (int r = 0; r < 16; ++r) s[r] += tb[27 - (r & 3) - 8 * (r >> 2)];
                osm3_tile(s, l, o, vB);
                LOADV4(vB, VWb + (size_t)(kb * 2) * 1024);
            }
        }
        const float lt = l + __shfl_xor(l, 32); const float sc = (lt > 0.f ? 1.f / lt : 0.f) * sigmoidf_(graw_w);
        f32x4 c[2][4];
#pragma unroll
        for (int dt = 0; dt < 2; ++dt)
#pragma unroll
            for (int rg = 0; rg < 4; ++rg) c[dt][rg] = *(const f32x4*)(mix + rowq * DM + hq * 64 + dt * 32 + 8 * rg + 4 * hf);
#pragma unroll
        for (int dt = 0; dt < 2; ++dt)
#pragma unroll
            for (int rg = 0; rg < 4; ++rg)
                *(f32x4*)(mix + rowq * DM + hq * 64 + dt * 32 + 8 * rg + 4 * hf) = (f32x4){c[dt][rg][0] + o[dt][4 * rg] * sc, c[dt][rg][1] + o[dt][4 * rg + 1] * sc, c[dt][rg][2] + o[dt][4 * rg + 2] * sc, c[dt][rg][3] + o[dt][4 * rg + 3] * sc};
    }
    {
        l = 0.f;
#pragma unroll
        for (int dt = 0; dt < 2; ++dt)
#pragma unroll
            for (int r = 0; r < 16; ++r) o[dt][r] = 0.f;
        unsigned U = msk;
#pragma unroll
        for (int off = 1; off < 32; off <<= 1) U |= (unsigned)__shfl_xor((int)U, off);
        U = (unsigned)__builtin_amdgcn_readfirstlane((int)U);
        int j0 = 32, s0 = 0; slc_next(U, j0, s0, q0, true);
        int j1 = j0, s1 = s0; slc_next(U, j1, s1, q0, false);
        int j2 = j1, s2 = s1; slc_next(U, j2, s2, q0, false);
        int j3 = j2, s3 = s2; slc_next(U, j3, s3, q0, false);
        if (j0 < 32) {
            const int ka = j0 * 64 + s0 * 32, kb = j1 < 32 ? j1 * 64 + s1 * 32 : ka;
            LOADK4F(kA, KSb + (size_t)(ka >> 5) * 2048); LOADV4(vA, VSb + (size_t)(ka >> 4) * 1024); LOADK4F(kB, KSb + (size_t)(kb >> 5) * 2048); LOADV4(vB, VSb + (size_t)(kb >> 4) * 1024);
            PIN4(kA); PIN4(vA); PIN4(kB); PIN4(vB);
        }
        while (j0 < 32) {
            const int k0 = j0 * 64 + s0 * 32, k1 = j1 * 64 + s1 * 32;
            const int k2 = j2 < 32 ? j2 * 64 + s2 * 32 : k0, k3 = j3 < 32 ? j3 * 64 + s3 * 32 : k0;
            {
                const float madd = ((msk >> j0) & 1u) ? 0.f : -1e30f;
                f32x16 s;
#pragma unroll
                for (int r = 0; r < 16; ++r) s[r] = madd;
                PRIO_HI();
#pragma unroll
                for (int kk = 0; kk < 4; ++kk) s = mfma32(kA[kk], qf[kk], s);
                PRIO_LO();
                LOADK4F(kA, KSb + (size_t)(k2 >> 5) * 2048);
                const LAS float* tb = tS + (tq - k0 + 5 - 4 * hf);
#pragma unroll
                for (int r = 0; r < 16; ++r) s[r] += tb[27 - (r & 3) - 8 * (r >> 2)];
                osm3_tile(s, l, o, vA);
                LOADV4(vA, VSb + (size_t)(k2 >> 4) * 1024);
            }
            {
                const bool real = j1 < 32;
                const float madd = (real && ((msk >> (j1 & 31)) & 1u)) ? 0.f : -1e30f;
                f32x16 s;
#pragma unroll
                for (int r = 0; r < 16; ++r) s[r] = madd;
                PRIO_HI();
#pragma unroll
                for (int kk = 0; kk < 4; ++kk) s = mfma32(kB[kk], qf[kk], s);
                PRIO_LO();
                LOADK4F(kB, KSb + (size_t)(k3 >> 5) * 2048);
                const LAS float* tb = real ? tS + (tq - k1 + 5 - 4 * hf) : tS;
#pragma unroll
                for (int r = 0; r < 16; ++r) s[r] += tb[27 - (r & 3) - 8 * (r >> 2)];
                osm3_tile(s, l, o, vB);
                LOADV4(vB, VSb + (size_t)(k3 >> 4) * 1024);
            }
            j0 = j2; s0 = s2; j1 = j3; s1 = s3;
            j2 = j3; s2 = s3; slc_next(U, j2, s2, q0, false);
            j3 = j2; s3 = s2; slc_next(U, j3, s3, q0, false);
        }
        const float lt = l + __shfl_xor(l, 32); const float sc = (lt > 0.f ? 1.f / lt : 0.f) * sigmoidf_(graw_s);
        f32x4 c[2][4];
#pragma unroll
        for (int dt = 0; dt < 2; ++dt)
#pragma unroll
            for (int rg = 0; rg < 4; ++rg) c[dt][rg] = *(const f32x4*)(mix + rowq * DM + hq * 64 + dt * 32 + 8 * rg + 4 * hf);
#pragma unroll
        for (int dt = 0; dt < 2; ++dt)
#pragma unroll
            for (int rg = 0; rg < 4; ++rg)
                *(f32x4*)(mix + rowq * DM + hq * 64 + dt * 32 + 8 * rg + 4 * hf) = (f32x4){c[dt][rg][0] + o[dt][4 * rg] * sc, c[dt][rg][1] + o[dt][4 * rg + 1] * sc, c[dt][rg][2] + o[dt][4 * rg + 2] * sc, c[dt][rg][3] + o[dt][4 * rg + 3] * sc};
    }
}

__device__ __forceinline__ void sb_unit(const Params& p, const int b, const int h, const int qt) {
    const int lane = otid() & 63, ql = lane & 31, hf = lane >> 5;
    const int q0 = qt * 32, tq = q0 + ql; const size_t rowq = (size_t)b * T + tq;
    float* mix = (float*)(p.ws + WS_MIX);
    const bf16_t* DQ = (const bf16_t*)(p.ws + WS_DQ);
    const bf16_t* DKb = (const bf16_t*)(p.ws + WS_DK) + (size_t)(b * 8 + h) * 64 * 2048;
    const bf16_t* DVb = (const bf16_t*)(p.ws + WS_DVT) + (size_t)(b * 8 + h) * 128 * 64 * 16;
    bf16x8 qf[4];
#pragma unroll
    for (int kk = 0; kk < 4; ++kk) qf[kk] = *(const bf16x8*)(DQ + rowq * 512 + h * 64 + kk * 16 + hf * 8);
    f32x16 o[2];
#pragma unroll
    for (int dt = 0; dt < 2; ++dt)
#pragma unroll
        for (int r = 0; r < 16; ++r) o[dt][r] = 0.f;
    float carry = 0.f;
    bf16x8 kA[4], kB[4], vA[4];
    LOADK4F(kA, DKb + (size_t)qt * 2048);
    PIN4(kA);
    for (int kt = qt; kt >= 0; --kt) {
        const int k0 = kt * 32, kp = kt > 0 ? kt - 1 : 0;
        LOADK4F(kB, DKb + (size_t)kp * 2048); LOADV4(vA, DVb + (size_t)(kt * 2) * 1024);
        f32x16 s;
#pragma unroll
        for (int r = 0; r < 16; ++r) s[r] = 0.f;
        PRIO_HI();
#pragma unroll
        for (int kk = 0; kk < 4; ++kk) s = mfma32(kA[kk], qf[kk], s);
        PRIO_LO();
        float lm[16];
#pragma unroll
        for (int r = 0; r < 16; ++r) {
            const int key = k0 + (r & 3) + 8 * (r >> 2) + 4 * hf; const bool valid = key < tq; const float z = s[r];
            const float sp = fmaxf(z, 0.f) + __logf(1.f + __expf(-fabsf(z)));
            lm[r] = valid ? -sp : 0.f; s[r] = valid ? z - sp : -1e30f;
        }
        float G[4], Go[4];
#pragma unroll
        for (int rg = 0; rg < 4; ++rg) { G[rg] = (lm[4 * rg] + lm[4 * rg + 1]) + (lm[4 * rg + 2] + lm[4 * rg + 3]); Go[rg] = __shfl_xor(G[rg], 32); }
        float after = carry;
#pragma unroll
        for (int rg = 3; rg >= 0; --rg) {
            float tail = after + (hf ? 0.f : Go[rg]);
#pragma unroll
            for (int j = 3; j >= 0; --j) { const int r = 4 * rg + j; const float a = s[r] > -1e29f ? __expf(s[r] + tail) : 0.f; tail += lm[r]; s[r] = a; }
            after += G[rg] + Go[rg];
        }
        carry = after;
#pragma unroll
        for (int kc = 0; kc < 2; ++kc) {
            const bf16x8 pb = pack8(s[8 * kc + 0], s[8 * kc + 1], s[8 * kc + 2], s[8 * kc + 3], s[8 * kc + 4], s[8 * kc + 5], s[8 * kc + 6], s[8 * kc + 7]);
#pragma unroll
            for (int dt = 0; dt < 2; ++dt) o[dt] = mfma32(vA[kc * 2 + dt], pb, o[dt]);
        }
        COPY4(kA, kB);
        if (__all(carry < -105.f ? 1 : 0)) break;
    }
#pragma unroll
    for (int dt = 0; dt < 2; ++dt)
#pragma unroll
        for (int rg = 0; rg < 4; ++rg)
            *(f32x4*)(mix + rowq * DM + 1536 + h * 64 + dt * 32 + 8 * rg + 4 * hf) = (f32x4){o[dt][4 * rg], o[dt][4 * rg + 1], o[dt][4 * rg + 2], o[dt][4 * rg + 3]};
}

__device__ __forceinline__ int rel_bucket_dev(const int n) {
    if (n < 16) return n;
    const float nf = (float)n;
    int large = 16 + (int)(logf(nf / 16.f) / 4.1588830833596715f * 16.f);
    return large < 31 ? large : 31;
}
#define XB_TMO      128
#define XB_XCNT(j)  (256  + 64 * (j))
#define XB_XSUB(j)  (1280 + 64 * (j))
#define XB_XGEN(j)  (2304 + 64 * (j))
#define XB_TOP      3328
#define XB_TOPGEN   3392
#define XCD_BAR_WORDS 3456
#define XB_SPIN_CAP (1u << 18)

__device__ __forceinline__ unsigned xb_ld(unsigned* p)              { return __hip_atomic_load(p, __ATOMIC_RELAXED, __HIP_MEMORY_SCOPE_AGENT); }
__device__ __forceinline__ unsigned xb_add(unsigned* p, unsigned v) { return __hip_atomic_fetch_add(p, v, __ATOMIC_RELAXED, __HIP_MEMORY_SCOPE_AGENT); }
__device__ __forceinline__ unsigned xb_xcc_id() { return (unsigned)__builtin_amdgcn_s_getreg((3 << 11) | 20) & 0xFu; }
#define XB_SPIN(cond, bar) do { unsigned _sp = 0; while (cond) { __builtin_amdgcn_s_sleep(1); \
    if ((++_sp & 255u) == 0u) { if (xb_ld(&(bar)[XB_TMO])) break; if (_sp > XB_SPIN_CAP) { atomicAdd(&(bar)[XB_TMO], 1u); break; } } } } while (0)

struct XcdBarrier {
    unsigned* bar; unsigned x;
    volatile LAS unsigned* st;
};

__device__ __forceinline__ XcdBarrier xcd_barrier_post(unsigned* bar, volatile LAS unsigned* st) {
    XcdBarrier b; b.bar = bar; b.x = xb_xcc_id(); b.st = st;
    if (threadIdx.x == 0) (void)xb_add(&bar[XB_XCNT(b.x)], 1u);
    return b;
}
__device__ __forceinline__ void xcd_barrier_complete(unsigned* bar, unsigned x, unsigned& nloc, unsigned& nx) {
    const unsigned G = gridDim.x * gridDim.y * gridDim.z;
    unsigned sum, cnt, mine, sp = 0u;
    for (;;) {
        sum = 0u; cnt = 0u; mine = 0u;
#pragma unroll
        for (unsigned j = 0; j < 16; ++j) { const unsigned c = xb_ld(&bar[XB_XCNT(j)]); sum += c; cnt += (c > 0u) ? 1u : 0u; mine = (j == x) ? c : mine; }
        if (sum == G) break;
        __builtin_amdgcn_s_sleep(1);
        if ((++sp & 255u) == 0u) { if (xb_ld(&bar[XB_TMO])) break; if (sp > XB_SPIN_CAP) { atomicAdd(&bar[XB_TMO], 1u); break; } }
    }
    nloc = mine > 0u ? mine : 1u; nx = cnt > 0u ? cnt : 1u;
}

__device__ __forceinline__ void xcd_barrier(const XcdBarrier& b) {
    asm volatile("s_waitcnt vmcnt(0)" ::: "memory");
    __syncthreads();
    if (threadIdx.x == 0) {
        unsigned* bar = b.bar;
        __builtin_amdgcn_s_waitcnt(0);
        unsigned nloc = b.st[0], nx = b.st[1];
        if (nloc == 0u) { xcd_barrier_complete(bar, b.x, nloc, nx); b.st[0] = nloc; b.st[1] = nx; }
        const unsigned old = xb_add(&bar[XB_XSUB(b.x)], 1u);
        const unsigned gen = old / nloc;
        if (old + 1u == (gen + 1u) * nloc) {
            __builtin_amdgcn_fence(__ATOMIC_RELEASE, "agent");
            asm volatile("s_waitcnt vmcnt(0)" ::: "memory");
            const unsigned og = xb_add(&bar[XB_TOP], 1u);
            const unsigned tg = og / nx;
            if (og + 1u == (tg + 1u) * nx) xb_add(&bar[XB_TOPGEN], 1u);
            else XB_SPIN(xb_ld(&bar[XB_TOPGEN]) == tg, bar);
            __builtin_amdgcn_fence(__ATOMIC_ACQUIRE, "agent");
            xb_add(&bar[XB_XGEN(b.x)], 1u);
            asm volatile("s_waitcnt vmcnt(0)" ::: "memory");
        } else {
            XB_SPIN(xb_ld(&bar[XB_XGEN(b.x)]) == gen, bar);
            __builtin_amdgcn_fence(__ATOMIC_ACQUIRE, "agent");
            asm volatile("s_waitcnt vmcnt(0)" ::: "memory");
        }
    }
    __syncthreads();
}

__device__ __forceinline__ void finalize_rows(const Params& p, const int layer) {
    const int lane = otid() & 63, wave = otid() >> 6;
    const float* mix = (const float*)(p.ws + WS_MIX); bf16_t* out = (bf16_t*)(p.ws + WS_ABUF); const float* gg = p.in[I_GG] + (size_t)layer * DM;
    f32x4 gav[4], gcv[4];
#pragma unroll
    for (int g = 0; g < 4; ++g) { gav[g] = *(const f32x4*)(gg + g * 512 + lane * 8); gcv[g] = *(const f32x4*)(gg + g * 512 + lane * 8 + 4); }
    for (int row = blockIdx.x * 8 + wave; row < MROWS; row += gridDim.x * 8) {
        f32x4 a[4], c[4];
#pragma unroll
        for (int g = 0; g < 4; ++g) { const float* src = mix + (size_t)row * DM + g * 512 + lane * 8; a[g] = *(const f32x4*)(src); c[g] = *(const f32x4*)(src + 4); }
#pragma unroll
        for (int g = 0; g < 4; ++g) {
            float ss = a[g][0] * a[g][0] + a[g][1] * a[g][1] + a[g][2] * a[g][2] + a[g][3] * a[g][3] + c[g][0] * c[g][0] + c[g][1] * c[g][1] + c[g][2] * c[g][2] + c[g][3] * c[g][3];
            ss = wave_sum(ss); const float r = rsqrtf(ss * (1.f / 512.f) + 1e-6f);
            const f32x4 ga = gav[g], gc = gcv[g];
            *(bf16x8*)(out + (size_t)row * DM + g * 512 + lane * 8) = pack8(a[g][0] * r * ga[0], a[g][1] * r * ga[1], a[g][2] * r * ga[2], a[g][3] * r * ga[3], c[g][0] * r * gc[0], c[g][1] * r * gc[1], c[g][2] * r * gc[2], c[g][3] * r * gc[3]);
        }
    }
}

__device__ __forceinline__ int q_grab(unsigned* ctr) {
    int v = 0; if ((otid() & 63) == 0) v = (int)__hip_atomic_fetch_add(ctr, 1u, __ATOMIC_RELAXED, __HIP_MEMORY_SCOPE_AGENT);
    return __builtin_amdgcn_readfirstlane(v);
}
#ifdef PROBE_SEQ
constexpr int PH_PER_LAYER = 10, N_PHASES = 4 * (sizeof((int[])PROBE_SEQ) / sizeof(int));
#else
constexpr int PH_PER_LAYER = 10, N_PHASES = 4 * PH_PER_LAYER;
#endif

__global__ void __launch_bounds__(512, 2) mk_fwd(Params p0) {
    extern __shared__ __attribute__((aligned(16))) unsigned char lds_raw[];
    LAS unsigned char* lds = (LAS unsigned char*)lds_raw;
    cg::grid_group grid = cg::this_grid();
    const int G = gridDim.x, blk = blockIdx.x;
    volatile LAS unsigned* xst = (volatile LAS unsigned*)(lds + LDS_BYTES - 16);
    { const int t0 = otid(); if (t0 < 4) xst[t0] = 0u; }
    __syncthreads();
    XcdBarrier xbar = xcd_barrier_post((unsigned*)(p0.ws + WS_BAR), xst);
    for (int ph = p0.ph_lo; ph < p0.ph_hi; ++ph) {
        if (ph == p0.ph_lo + 1) grid.sync();
        else if (ph > p0.ph_lo) xcd_barrier(xbar);
        Params p = p0;
        {
            typedef __attribute__((address_space(1))) unsigned char* gp_t;
            gp_t gws = (gp_t)p0.ws, gout = (gp_t)p0.out;
            asm volatile("" : "+s"(gws), "+s"(gout));
            p.ws = (unsigned char*)gws; p.out = (float*)gout;
        }
#define LAUNDER_IN(i) do { typedef __attribute__((address_space(1))) unsigned char* gp2_t; gp2_t gi_ = (gp2_t)p0.in[i]; asm volatile("" : "+s"(gi_)); p.in[i] = (const float*)gi_; } while (0)
        bf16_t* abuf = (bf16_t*)(p.ws + WS_ABUF);
#ifdef PROBE_SEQ
        constexpr int kSeq[] = PROBE_SEQ; constexpr int kSeqN = sizeof(kSeq) / sizeof(int);
        const int layer = ph / kSeqN; int sp = 0;
#pragma unroll
        for (int i = 0; i < kSeqN; ++i) if (ph % kSeqN == i) sp = kSeq[i];
#else
        const int layer = ph / PH_PER_LAYER, sp = ph % PH_PER_LAYER;
#endif
#ifdef REPEAT_SP
        for (int rep = 0; rep < ((sp == REPEAT_SP) ? 2 : 1); ++rep) {
        __syncthreads();
#endif
        if (sp == 0) {
            LAUNDER_IN(I_X); LAUNDER_IN(I_NMIX); LAUNDER_IN(I_WIN); LAUNDER_IN(I_WOUT); LAUNDER_IN(I_WG); LAUNDER_IN(I_WU); LAUNDER_IN(I_WD);
#ifndef SKIP_P0
            phase_weights(p, layer, lds);
            rmsnorm_rows(layer == 0 ? p.in[I_X] : p.out, p.in[I_NMIX] + (size_t)layer * DM, abuf);
#endif
        } else if (sp == 1) {
            pg8::Gemm g{abuf, (const bf16_t*)(p.ws + WS_WIN), MROWS, NPJ, DM}; pg8::StaticOrder S; S.init(MROWS, NPJ, G, blk);
            EpiF32 E{(bf16_t*)(p.ws + WS_PROJ), NPJ};
#ifndef SKIP_G1
            pg8::gemm_phase<EpiF32, pg8::StaticOrder, true, true>(lds, g, S, E);
            LAUNDER_IN(I_WOUT); LAUNDER_IN(I_WG); LAUNDER_IN(I_WU); LAUNDER_IN(I_WD);
            weights_queue(p, layer, lds, (unsigned*)(p.ws + WS_BAR + 16384 + 4096) + layer * 16);
#endif
        } else if (sp == 2) {
            LAUNDER_IN(I_QG); LAUNDER_IN(I_KG); LAUNDER_IN(I_CONV); LAUNDER_IN(I_SGW); LAUNDER_IN(I_SGB); LAUNDER_IN(I_CPOS); LAUNDER_IN(I_CW1); LAUNDER_IN(I_CW2); LAUNDER_IN(I_REL);
            for (int u = blk; u < 256; u += G) token_prep_unit(p, layer, u);
            for (int u = blk; u < 256; u += G) sgu_unit(p, layer, u, lds);
            for (int u = blk; u < 256; u += G) compress_unit(p, layer, u, lds);
            {
                const int tid = otid();
                if (blk == 0 && tid < 64) {
                    float gq = fabsf(p.in[I_QG][layer * 64 + tid]), gk = fabsf(p.in[I_KG][layer * 64 + tid]);
                    const float r0 = p.in[I_REL][tid], r1 = p.in[I_REL][tid + 64], r2 = p.in[I_REL][tid + 128], r3 = p.in[I_REL][tid + 192];
                    float bm = fmaxf(fmaxf(fabsf(r0), fabsf(r1)), fmaxf(fabsf(r2), fabsf(r3)));
#pragma unroll
                    for (int o = 1; o < 64; o <<= 1) { gq = fmaxf(gq, __shfl_xor(gq, o)); gk = fmaxf(gk, __shfl_xor(gk, o)); }
#pragma unroll
                    for (int o = 8; o < 64; o <<= 1) bm = fmaxf(bm, __shfl_xor(bm, o));
                    if (tid < 8) ((float*)(p.ws + WS_BAR + 16384 + 16384 - 64))[tid] = fminf(64.f * 0.125f * LOG2E * gq * gk + bm * LOG2E, 60.f);
                }
            }
        } else if (sp == 3) {
            LAUNDER_IN(I_REL);
            const int tid = otid(), wave = __builtin_amdgcn_readfirstlane(tid >> 6);
            LAS float* tbl = (LAS float*)lds; const float* m0g = (const float*)(p.ws + WS_BAR + 16384 + 16384 - 64);
            for (int idx = tid; idx < TBL_ALL; idx += 512) {
                const int h = idx / TBL_H, i = idx - h * TBL_H; const bool isS = i < TS_N; const int dist = (isS ? i : i - TS_N) - 32;
                const bool ok = dist >= 0 && (isS || dist < 512);
                tbl[idx] = ok ? p.in[I_REL][rel_bucket_dev(dist) * 8 + h] * LOG2E - m0g[h] : -1e30f;
            }
            __syncthreads();
            const int gw = wave * G + blk, NW = 8 * G;
            if (NW >= 2048 && (G & 7) == 0) {
                if (gw < 1024) {
#ifndef SKIP_NSA
                    cmp_unit(p, gw, tbl, tbl + TBL_ALL + wave * 1024, tbl + TBL_ALL + 8192 + wave * 1024);
#endif
                }
                unsigned* ctr = (unsigned*)(p.ws + WS_BAR + 16384) + (layer * 8 + (blk & 7)) * 16;
                int u = q_grab(ctr);
                while (u < 512) {
                    const int un = q_grab(ctr);
#ifndef SKIP_SB
                    sb_unit(p, blk & 7, u & 7, 63 - (u >> 3));
#endif
                    u = un;
                }
            } else {
                for (int un = gw; un < 1024; un += NW) cmp_unit(p, un, tbl, tbl + TBL_ALL + wave * 1024, tbl + TBL_ALL + 8192 + wave * 1024);
                for (int ud = gw; ud < 4096; ud += NW) { const int bh = ud & 63; sb_unit(p, bh & 7, bh >> 3, 63 - (ud >> 6)); }
            }
        } else if (sp == 4) {
            const int tid = otid(), wave = __builtin_amdgcn_readfirstlane(tid >> 6);
            const LAS float* tbl = (const LAS float*)lds;
            if ((G & 7) == 0) {
                unsigned* ctr = (unsigned*)(p.ws + WS_BAR + 16384 + 8192) + (layer * 8 + (blk & 7)) * 16;
                int u = q_grab(ctr);
                while (u < 512) {
                    const int un = q_grab(ctr);
#ifndef SKIP_WS
                    ws_unit(p, blk & 7, u & 7, 63 - (u >> 3), tbl);
#endif
                    u = un;
                }
            } else {
                const int gw = wave * G + blk, NW = 8 * G;
                for (int uu = gw; uu < 2048; uu += NW) {
                    const int bh = uu & 63, qa = uu >> 6;
                    ws_unit(p, bh & 7, bh >> 3, 63 - qa, tbl);
                    ws_unit(p, bh & 7, bh >> 3, qa, tbl);
                }
            }
        } else if (sp == 5) {
            LAUNDER_IN(I_GG);
#ifndef SKIP_FIN
            finalize_rows(p, layer);
#endif
        } else if (sp == 6) {
            LAUNDER_IN(I_X);
            pg8::Gemm g{abuf, (const bf16_t*)(p.ws + WS_WOUT), MROWS, DM, DM}; pg8::StaticOrder S; S.init(MROWS, DM, G, blk);
            EpiResid E{layer == 0 ? p.in[I_X] : p.out, p.out, DM};
#ifndef SKIP_G2
            pg8::gemm_phase<EpiResid, pg8::StaticOrder, true, true>(lds, g, S, E);
#endif
        } else if (sp == 7) {
            LAUNDER_IN(I_NFFN);
#ifndef SKIP_RN
            rmsnorm_rows(p.out, p.in[I_NFFN] + (size_t)layer * DM, abuf);
#endif
        } else if (sp == 8) {
            pg8::Gemm g{abuf, (const bf16_t*)(p.ws + WS_WGU), MROWS, NGU, DM}; pg8::StaticOrder S; S.init(MROWS, NGU, G, blk);
            EpiSwiglu E{(bf16_t*)(p.ws + WS_PROJ), DFF};
#ifndef SKIP_G3
            pg8::gemm_phase<EpiSwiglu, pg8::StaticOrder, true, true>(lds, g, S, E);
#endif
        } else {
            pg8::Gemm g{(const bf16_t*)(p.ws + WS_PROJ), (const bf16_t*)(p.ws + WS_WDN), MROWS, DM, DFF}; pg8::StaticOrder S; S.init(MROWS, DM, G, blk);
            EpiResid E{p.out, p.out, DM};
#ifndef SKIP_G2
            pg8::gemm_phase<EpiResid, pg8::StaticOrder, true, true>(lds, g, S, E);
#endif
        }
#ifdef REPEAT_SP
        }
#endif
    }
}

extern "C" void kernel_launch(void* const* d_in, const int* in_sizes, int n_in, void* d_out, int out_size, void* d_ws, size_t ws_size, hipStream_t stream) {
    static int grid_blocks = 0;
    if (!grid_blocks) {
        hipFuncSetAttribute((const void*)mk_fwd, hipFuncAttributeMaxDynamicSharedMemorySize, LDS_BYTES);
        int dev = 0, cus = 0, per_cu = 0;
        hipGetDevice(&dev);
        hipDeviceGetAttribute(&cus, hipDeviceAttributeMultiprocessorCount, dev);
        hipOccupancyMaxActiveBlocksPerMultiprocessor(&per_cu, mk_fwd, 512, LDS_BYTES);
        if (per_cu < 1) fprintf(stderr, "occupancy query returned %d\n", per_cu);
        grid_blocks = cus;
    }
    if (ws_size < WS_END) { fprintf(stderr, "workspace too small: %zu < %zu\n", ws_size, (size_t)WS_END); return; }
    Params p{};
    for (int i = 0; i < 18; ++i) p.in[i] = (const float*)d_in[i];
    p.out = (float*)d_out; p.ws = (unsigned char*)d_ws; p.ph_lo = 0; p.ph_hi = N_PHASES;
    void* args[] = {&p};
    (void)hipMemsetAsync((unsigned char*)d_ws + WS_BAR, 0, 32768, stream);
    hipError_t e = hipLaunchCooperativeKernel((void*)mk_fwd, dim3(grid_blocks), dim3(512), args, LDS_BYTES, stream);
    if (e != hipSuccess) fprintf(stderr, "cooperative launch failed: %s (grid %d)\n", hipGetErrorString(e), grid_blocks);
}
```

```cpp
#include <hip/hip_runtime.h>
#include <hip/hip_cooperative_groups.h>
#include <cstdio>
#include <cstdint>
namespace cg = cooperative_groups;
__device__ __forceinline__ int otid() { int t = threadIdx.x; asm volatile("" : "+v"(t)); return t; }
namespace pg8 {
#define PG8_LAS __attribute__((address_space(3)))
typedef unsigned short bf16_t;
typedef short bf16x8 __attribute__((ext_vector_type(8)));
typedef float f32x4 __attribute__((ext_vector_type(4)));
typedef unsigned u32x4 __attribute__((ext_vector_type(4)));
constexpr int BM = 256, BK = 64, HALF = 128, HTB = HALF * BK * 2  , STAGE_BYTES = 8 * HTB, NXCD = 8, WGM = 8;

__host__ __device__ __forceinline__ int lds_byte(int r, int c) { const int st = (r >> 4) * 2 + (c >> 5), rr = r & 15, cc = c & 31, ob = rr * 64 + cc * 2; return st * 1024 + (ob ^ (((ob >> 9) & 1) << 5)); }
__host__ __device__ __forceinline__ void stage_rc(int b, int& R, int& C) { const int st = b / 1024, sb = b % 1024, swz = sb ^ (((sb >> 9) & 1) << 5); R = (st >> 1) * 16 + swz / 64; C = (st & 1) * 32 + (swz % 64) / 2; }
__host__ __device__ __forceinline__ int perm32(int rho) { const int n = rho >> 4, i = rho & 15; return 8 * (i >> 2) + 4 * n + (i & 3); }

struct Unit { int pm, pn; };
struct Gemm { const bf16_t* A; const bf16_t* Bt; int M, N, K; };

struct StaticOrder {
    int nM, nN, nwg, G, c;
    __host__ __device__ void init(int M, int N, int G_, int c_) { nM = M / BM; nN = N / BM; nwg = nM * nN; G = G_; c = c_; }
    __host__ __device__ bool next(int i, Unit& u) const {
        const long L = (long)i * G + c; if (L >= nwg) return false;
        int wgid = (int)L; { const int q = nwg / NXCD, r = nwg % NXCD, xcd = wgid % NXCD, off = wgid / NXCD; wgid = (xcd < r ? xcd * (q + 1) : r * (q + 1) + (xcd - r) * q) + off; }
        const int nig = WGM * nN, gid = wgid / nig, fm = gid * WGM, gsz = (nM - fm) < WGM ? (nM - fm) : WGM;
        u.pm = fm + ((wgid % nig) % gsz); u.pn = (wgid % nig) / gsz; return true;
    }
    __device__ __forceinline__ void a_ready(const Unit&) const {}
    __device__ __forceinline__ void done(const Unit&) const {}
};

__device__ __forceinline__ unsigned cvt_pk_bf16(float lo, float hi) { unsigned r; asm volatile("v_cvt_pk_bf16_f32 %0, %1, %2" : "=v"(r) : "v"(lo), "v"(hi)); return r; }
template <class Epi, class Sched, bool ALIGN_EPI = false, bool SP2 = false>
__device__ __forceinline__ void gemm_phase(PG8_LAS unsigned char* lds, const Gemm g, const Sched& S, const Epi& E) {
    const int tid = otid(), wid = __builtin_amdgcn_readfirstlane(tid >> 6), lane = tid & 63, wr = wid >> 2, wc = wid & 3, fr = lane & 15, fq = lane >> 4;
    const int K = g.K, nt = K / BK;
    unsigned voffA[2], voffB[2];
#pragma unroll
    for (int i = 0; i < 2; ++i) { int R, C; stage_rc(tid * 16 + i * 8192, R, C); const int Rb = Epi::PERM ? ((R & ~31) + perm32(R & 31)) : R;
        voffA[i] = (unsigned)(R * K + C) * 2u; voffB[i] = (unsigned)(Rb * K + C) * 2u; }
    const size_t kstep = (size_t)(BK * 2);
    const size_t hstep = (size_t)HALF * K * 2;
    const size_t tstep = 2 * hstep;
    const unsigned ldsw = (unsigned)wid * 1024u;
    const int aoff = lds_byte(wr * 64 + fr, fq * 8), boff = lds_byte(wc * 32 + fr, fq * 8);
#define PG8_SA(b, h) (((b) * 2 + (h)) * HTB)
#define PG8_SB(b, h) ((4 + (b) * 2 + (h)) * HTB)
#define PG8_STAGE(bufoff, gbase, voff) do { _Pragma("unroll") for (int _i = 0; _i < 2; ++_i) \
        __builtin_amdgcn_global_load_lds((const unsigned*)((const char*)(gbase) + (voff)[_i]), (PG8_LAS unsigned*)(lds + (bufoff) + ldsw + _i * 8192), 16, 0, 0); } while (0)
#define PG8_LDA(dst, b, h) do { _Pragma("unroll") for (int m = 0; m < 4; ++m) _Pragma("unroll") for (int k = 0; k < 2; ++k) dst[m][k] = *(const PG8_LAS bf16x8*)(lds + PG8_SA(b, h) + aoff + m * 2048 + k * 1024); } while (0)
#define PG8_LDB(dst, b, h) do { _Pragma("unroll") for (int n = 0; n < 2; ++n) _Pragma("unroll") for (int k = 0; k < 2; ++k) dst[n][k] = *(const PG8_LAS bf16x8*)(lds + PG8_SB(b, h) + boff + n * 2048 + k * 1024); } while (0)
#define PG8_MMA(ai, bj, At, Bt) do { __builtin_amdgcn_s_setprio(1); _Pragma("unroll") for (int m = 0; m < 4; ++m) _Pragma("unroll") for (int n = 0; n < 2; ++n) _Pragma("unroll") for (int k = 0; k < 2; ++k) \
        acc[ai][bj][m][n] = __builtin_amdgcn_mfma_f32_16x16x32_bf16(Bt[n][k], At[m][k], acc[ai][bj][m][n], 0, 0, 0); __builtin_amdgcn_s_setprio(0); } while (0)
#define PG8_WAIT_V(n) asm volatile("s_waitcnt vmcnt(" #n ")" ::: "memory")
#define PG8_WAIT_L(n) asm volatile("s_waitcnt lgkmcnt(" #n ")" ::: "memory")
#define PG8_BAR __builtin_amdgcn_s_barrier()
#define PG8_SCHED __builtin_amdgcn_sched_barrier(0)
    Unit cur, nxt; int ui = 0;
    if (!S.next(0, cur)) return;
    f32x4 acc[2][2][4][2];
#pragma unroll
    for (int a = 0; a < 2; ++a)
#pragma unroll
        for (int b = 0; b < 2; ++b)
#pragma unroll
            for (int m = 0; m < 4; ++m)
#pragma unroll
                for (int n = 0; n < 2; ++n) acc[a][b][m][n] = (f32x4){0.f, 0.f, 0.f, 0.f};
    bf16x8 At[4][2], B0[2][2], B1[2][2];
    const char* cA = (const char*)g.A + (size_t)cur.pm * tstep; const char* cB = (const char*)g.Bt + (size_t)cur.pn * tstep;
    S.a_ready(cur);
    if constexpr (SP2) {
        PG8_STAGE(PG8_SB(0, 0), cB, voffB); PG8_STAGE(PG8_SB(0, 1), cB + hstep, voffB); PG8_STAGE(PG8_SA(0, 0), cA, voffA); PG8_STAGE(PG8_SA(0, 1), cA + hstep, voffA);
        if (wr == 1) PG8_BAR;
        PG8_WAIT_V(2); PG8_BAR;
        PG8_STAGE(PG8_SB(1, 0), cB + kstep, voffB); PG8_STAGE(PG8_SA(1, 0), cA + kstep, voffA); PG8_STAGE(PG8_SB(1, 1), cB + hstep + kstep, voffB);
        PG8_WAIT_V(6); PG8_BAR;
    } else {
        PG8_STAGE(PG8_SB(0, 0), cB, voffB); PG8_STAGE(PG8_SA(0, 0), cA, voffA); PG8_STAGE(PG8_SB(0, 1), cB + hstep, voffB); PG8_STAGE(PG8_SA(0, 1), cA + hstep, voffA);
        if (wr == 1) PG8_BAR;
        PG8_WAIT_V(4); PG8_BAR;
        PG8_STAGE(PG8_SB(1, 0), cB + kstep, voffB); PG8_STAGE(PG8_SA(1, 0), cA + kstep, voffA); PG8_STAGE(PG8_SB(1, 1), cB + hstep + kstep, voffB);
        PG8_WAIT_V(6); PG8_BAR;
    }
    for (;;) {
        const bool has_next = S.next(ui + 1, nxt);
        const char* nA = has_next ? (const char*)g.A + (size_t)nxt.pm * tstep : cA; const char* nB = has_next ? (const char*)g.Bt + (size_t)nxt.pn * tstep : cB;
        for (int t = 0; t < nt; t += 2) {
            const bool last = (t == nt - 2);
            const char* a1 = cA + (size_t)(t + 1) * kstep;
            const char* a2 = last ? nA : cA + (size_t)(t + 2) * kstep; const char* b2 = last ? nB : cB + (size_t)(t + 2) * kstep;
            const char* a3 = a2 + kstep; const char* b3 = b2 + kstep;
            if (last && has_next) S.a_ready(nxt);
            if constexpr (SP2) {
            PG8_LDB(B0, 0, 0); PG8_LDB(B1, 0, 1); PG8_SCHED; PG8_LDA(At, 0, 0); PG8_STAGE(PG8_SA(1, 1), a1 + hstep, voffA);
            PG8_WAIT_V(8); PG8_WAIT_L(0); PG8_BAR; PG8_MMA(0, 0, At, B0); PG8_MMA(0, 1, At, B1); PG8_BAR; PG8_SCHED;
            PG8_LDA(At, 0, 1); PG8_STAGE(PG8_SB(0, 0), b2, voffB); PG8_STAGE(PG8_SB(0, 1), b2 + hstep, voffB); PG8_STAGE(PG8_SA(0, 0), a2, voffA);
            PG8_WAIT_V(8); PG8_WAIT_L(0); PG8_BAR; PG8_MMA(1, 0, At, B0); PG8_MMA(1, 1, At, B1); PG8_BAR; PG8_SCHED;
            PG8_LDB(B0, 1, 0); PG8_LDB(B1, 1, 1); PG8_SCHED; PG8_LDA(At, 1, 0); PG8_STAGE(PG8_SA(0, 1), a2 + hstep, voffA);
            PG8_WAIT_V(8); PG8_WAIT_L(0); PG8_BAR; PG8_MMA(0, 0, At, B0); PG8_MMA(0, 1, At, B1); PG8_BAR; PG8_SCHED;
            PG8_LDA(At, 1, 1); PG8_STAGE(PG8_SB(1, 0), b3, voffB); PG8_STAGE(PG8_SB(1, 1), b3 + hstep, voffB); PG8_STAGE(PG8_SA(1, 0), a3, voffA);
            PG8_WAIT_V(8); PG8_WAIT_L(0); PG8_BAR; PG8_MMA(1, 0, At, B0); PG8_MMA(1, 1, At, B1); PG8_BAR; PG8_SCHED;
            } else {
            PG8_LDB(B0, 0, 0); PG8_SCHED; PG8_LDA(At, 0, 0); PG8_STAGE(PG8_SA(1, 1), a1 + hstep, voffA);
            PG8_WAIT_L(8); PG8_BAR; PG8_WAIT_L(0); PG8_MMA(0, 0, At, B0); PG8_BAR; PG8_SCHED;
            PG8_LDB(B1, 0, 1); PG8_STAGE(PG8_SB(0, 0), b2, voffB);
            PG8_BAR; PG8_WAIT_L(0); PG8_MMA(0, 1, At, B1); PG8_BAR;
            PG8_LDA(At, 0, 1); PG8_STAGE(PG8_SA(0, 0), a2, voffA);
            PG8_BAR; PG8_WAIT_L(0); PG8_MMA(1, 0, At, B0); PG8_BAR; PG8_SCHED;
            PG8_STAGE(PG8_SB(0, 1), b2 + hstep, voffB);
            PG8_WAIT_V(6); PG8_BAR; PG8_MMA(1, 1, At, B1); PG8_BAR;
            PG8_LDB(B0, 1, 0); PG8_SCHED; PG8_LDA(At, 1, 0); PG8_STAGE(PG8_SA(0, 1), a2 + hstep, voffA);
            PG8_WAIT_L(8); PG8_BAR; PG8_WAIT_L(0); PG8_MMA(0, 0, At, B0); PG8_BAR; PG8_SCHED;
            PG8_LDB(B1, 1, 1); PG8_STAGE(PG8_SB(1, 0), b3, voffB);
            PG8_BAR; PG8_WAIT_L(0); PG8_MMA(0, 1, At, B1); PG8_BAR;
            PG8_LDA(At, 1, 1); PG8_STAGE(PG8_SA(1, 0), a3, voffA);
            PG8_BAR; PG8_WAIT_L(0); PG8_MMA(1, 0, At, B0); PG8_BAR; PG8_SCHED;
            PG8_STAGE(PG8_SB(1, 1), b3 + hstep, voffB);
            PG8_WAIT_V(6); PG8_BAR; PG8_MMA(1, 1, At, B1); PG8_BAR;
            }
        }
        if constexpr (ALIGN_EPI) { if (wr == 0) PG8_BAR; }
        if constexpr (!Epi::AFTER_DRAIN) { E(acc, cur, wr, wc, fr, fq); S.done(cur); }
        if (!has_next) break;
#pragma unroll
        for (int a = 0; a < 2; ++a)
#pragma unroll
            for (int b = 0; b < 2; ++b)
#pragma unroll
                for (int m = 0; m < 4; ++m)
#pragma unroll
                    for (int n = 0; n < 2; ++n) acc[a][b][m][n] = (f32x4){0.f, 0.f, 0.f, 0.f};
        cur = nxt; cA = nA; cB = nB; ++ui;
        if constexpr (ALIGN_EPI) { if (wr == 1) PG8_BAR; }
    }
    PG8_WAIT_V(0);
    if constexpr (!ALIGN_EPI) { if (wr == 0) PG8_BAR; }
    PG8_BAR;
    if constexpr (Epi::AFTER_DRAIN) { E.fused(acc, cur, wr, wc, fr, fq, lds, wid, lane); S.done(cur); }
#undef PG8_SA
#undef PG8_SB
#undef PG8_STAGE
#undef PG8_LDA
#undef PG8_LDB
#undef PG8_MMA
#undef PG8_WAIT_V
#undef PG8_WAIT_L
#undef PG8_BAR
#undef PG8_SCHED
}
}
using pg8::bf16_t; using pg8::bf16x8; using pg8::f32x4; using pg8::u32x4; using pg8::cvt_pk_bf16;
typedef float f32x16 __attribute__((ext_vector_type(16)));
typedef unsigned u32x2 __attribute__((ext_vector_type(2)));
#define LAS __attribute__((address_space(3)))

constexpr int T = 2048, MROWS = 16384, DM = 2048, NPJ = 5632, DFF = 5632, NGU = 11264, NIN = 5400;
constexpr int C_KC = 512, C_VC = 640, C_KS = 768, C_VS = 896, C_KW = 1024, C_VW = 1152, C_AG = 1280, C_BG = 1304, C_CG = 1816, C_BH = 2328,
              C_CU = 2840, C_CV = 3352, C_DQ = 3864, C_DK = 4376, C_DV = 4888;
constexpr int LDS_BYTES = 159744;

constexpr size_t WS_WIN = 0;
constexpr size_t WS_WOUT = WS_WIN + (size_t)NPJ * DM * 2;
constexpr size_t WS_WGU = WS_WOUT + (size_t)DM * DM * 2;
constexpr size_t WS_WDN = WS_WGU + (size_t)NGU * DM * 2;
constexpr size_t WS_ABUF = WS_WDN + (size_t)DM * DFF * 2;
constexpr size_t WS_PROJ = WS_ABUF + (size_t)MROWS * DM * 2;
constexpr size_t WS_MIX = WS_PROJ + (size_t)MROWS * NPJ * 4;
constexpr size_t WS_QN = WS_MIX + (size_t)MROWS * DM * 4;
constexpr size_t WS_KS = WS_QN + (size_t)MROWS * 512 * 2;
constexpr size_t WS_KW = WS_KS + (size_t)MROWS * 128 * 2;
constexpr size_t WS_VST = WS_KW + (size_t)MROWS * 128 * 2;
constexpr size_t WS_VWT = WS_VST + (size_t)MROWS * 128 * 2;
constexpr size_t WS_KCN = WS_VWT + (size_t)MROWS * 128 * 2;
constexpr size_t WS_VCT = WS_KCN + (size_t)16 * 128 * 64 * 2;
constexpr size_t WS_DQ = WS_VCT + (size_t)16 * 128 * 64 * 2;
constexpr size_t WS_DK = WS_DQ + (size_t)MROWS * 512 * 2;
constexpr size_t WS_DVT = WS_DK + (size_t)MROWS * 512 * 2;
constexpr size_t WS_MSK = WS_DVT + (size_t)MROWS * 512 * 2;
constexpr size_t WS_BAR = WS_MSK + (size_t)16 * 2048 * 4;
constexpr size_t WS_END = WS_BAR + 32768;

struct Params { const float* in[18]; float* out; unsigned char* ws; int ph_lo, ph_hi; };
enum { I_X = 0, I_WIN, I_WOUT, I_NMIX, I_NFFN, I_QG, I_KG, I_CPOS, I_CW1, I_CW2, I_REL, I_CONV, I_SGW, I_SGB, I_GG, I_WG, I_WU, I_WD };

__device__ __forceinline__ float wave_sum(float v) {
#pragma unroll
    for (int o = 1; o < 64; o <<= 1) v += __shfl_xor(v, o);
    return v;
}
__device__ __forceinline__ float gelu_tanh(float x) {
    const float u = 0.7978845608028654f * (x + 0.044715f * x * x * x);
    const float e = __expf(2.f * u);
    const float th = 1.f - 2.f / (e + 1.f);
    return 0.5f * x * (1.f + th);
}
__device__ __forceinline__ float sigmoidf_(float x) { return 1.f / (1.f + __expf(-x)); }
__device__ __forceinline__ bf16x8 pack8(float a0, float a1, float a2, float a3, float a4, float a5, float a6, float a7) {
    u32x4 w; w.x = cvt_pk_bf16(a0, a1); w.y = cvt_pk_bf16(a2, a3); w.z = cvt_pk_bf16(a4, a5); w.w = cvt_pk_bf16(a6, a7);
    return __builtin_bit_cast(bf16x8, w);
}
__device__ __forceinline__ float bf2f(bf16_t b) { return __uint_as_float((unsigned)b << 16); }
__device__ __forceinline__ float bflo(unsigned u) { return __uint_as_float(u << 16); }
__device__ __forceinline__ float bfhi(unsigned u) { return __uint_as_float(u & 0xffff0000u); }
struct F8 { f32x4 a, b; };
__device__ __forceinline__ F8 ld8(const bf16_t* p) {
    const u32x4 w = *(const u32x4*)p; F8 r;
    r.a = (f32x4){bflo(w.x), bfhi(w.x), bflo(w.y), bfhi(w.y)}; r.b = (f32x4){bflo(w.z), bfhi(w.z), bflo(w.w), bfhi(w.w)}; return r;
}
__device__ __forceinline__ F8 up8(const u32x4 w) { F8 r; r.a = (f32x4){bflo(w.x), bfhi(w.x), bflo(w.y), bfhi(w.y)}; r.b = (f32x4){bflo(w.z), bfhi(w.z), bflo(w.w), bfhi(w.w)}; return r; }
__device__ __forceinline__ bf16_t bf1(float a) { return (bf16_t)(cvt_pk_bf16(a, 0.f) & 0xffffu); }
__device__ __forceinline__ f32x16 mfma32(bf16x8 a, bf16x8 b, f32x16 c) { return __builtin_amdgcn_mfma_f32_32x32x16_bf16(a, b, c, 0, 0, 0); }
__device__ __forceinline__ int slot16(int ko) { return ((ko >> 2) & 1) * 8 + (ko >> 3) * 4 + (ko & 3); }

struct EpiF32 {
    static constexpr bool PERM = true, AFTER_DRAIN = false; bf16_t* O; int ldc;
    __device__ __forceinline__ void operator()(const f32x4 (&acc)[2][2][4][2], const pg8::Unit& u, int wr, int wc, int fr, int fq) const {
#pragma unroll
        for (int ai = 0; ai < 2; ++ai)
#pragma unroll
            for (int m = 0; m < 4; ++m) {
                bf16_t* rp = O + (size_t)(u.pm * 256 + ai * 128 + wr * 64 + m * 16 + fr) * ldc + u.pn * 256 + wc * 32 + fq * 8;
#pragma unroll
                for (int bj = 0; bj < 2; ++bj) {
                    const f32x4 v0 = acc[ai][bj][m][0], v1 = acc[ai][bj][m][1]; u32x4 w;
                    w.x = cvt_pk_bf16(v0[0], v0[1]); w.y = cvt_pk_bf16(v0[2], v0[3]); w.z = cvt_pk_bf16(v1[0], v1[1]); w.w = cvt_pk_bf16(v1[2], v1[3]);
                    *(u32x4*)(rp + bj * 128) = w;
                }
            }
    }
};
struct EpiResid {
    static constexpr bool PERM = true, AFTER_DRAIN = false; const float* base; float* out; int ldc;
    __device__ __forceinline__ void operator()(const f32x4 (&acc)[2][2][4][2], const pg8::Unit& u, int wr, int wc, int fr, int fq) const {
        const size_t off0 = (size_t)(u.pm * 256 + wr * 64 + fr) * ldc + u.pn * 256 + wc * 32 + fq * 8;
        f32x4 cur[2][2], nxt[2][2];
#pragma unroll
        for (int bj = 0; bj < 2; ++bj) { cur[bj][0] = *(const f32x4*)(base + off0 + bj * 128); cur[bj][1] = *(const f32x4*)(base + off0 + bj * 128 + 4); }
#pragma unroll
        for (int idx = 0; idx < 8; ++idx) {
            const int ai = idx >> 2, m = idx & 3; const size_t off = off0 + (size_t)(ai * 128 + m * 16) * ldc;
            if (idx < 7) {
                const size_t offn = off0 + (size_t)(((idx + 1) >> 2) * 128 + ((idx + 1) & 3) * 16) * ldc;
#pragma unroll
                for (int bj = 0; bj < 2; ++bj) { nxt[bj][0] = *(const f32x4*)(base + offn + bj * 128); nxt[bj][1] = *(const f32x4*)(base + offn + bj * 128 + 4); }
            }
#pragma unroll
            for (int bj = 0; bj < 2; ++bj) { *(f32x4*)(out + off + bj * 128) = cur[bj][0] + acc[ai][bj][m][0]; *(f32x4*)(out + off + bj * 128 + 4) = cur[bj][1] + acc[ai][bj][m][1]; }
#pragma unroll
            for (int bj = 0; bj < 2; ++bj) { cur[bj][0] = nxt[bj][0]; cur[bj][1] = nxt[bj][1]; }
        }
    }
};
struct EpiSwiglu {
    static constexpr bool PERM = true, AFTER_DRAIN = false; bf16_t* O; int ldc;
    __device__ __forceinline__ void operator()(const f32x4 (&acc)[2][2][4][2], const pg8::Unit& u, int wr, int wc, int fr, int fq) const {
#pragma unroll
        for (int ai = 0; ai < 2; ++ai)
#pragma unroll
            for (int m = 0; m < 4; ++m) {
                bf16_t* rp = O + (size_t)(u.pm * 256 + ai * 128 + wr * 64 + m * 16 + fr) * ldc + u.pn * 128 + wc * 32 + fq * 8;
                float r[8];
#pragma unroll
                for (int n = 0; n < 2; ++n) {
                    const f32x4 g = acc[ai][0][m][n], uu = acc[ai][1][m][n];
#pragma unroll
                    for (int j = 0; j < 4; ++j) r[4 * n + j] = g[j] * __builtin_amdgcn_rcpf(1.f + __builtin_amdgcn_exp2f(g[j] * -1.4426950408889634f)) * uu[j];
                }
                *(bf16x8*)rp = pack8(r[0], r[1], r[2], r[3], r[4], r[5], r[6], r[7]);
            }
    }
};

__device__ __forceinline__ void tt_load(const float* s0, const float* s1, const int mode, const int Nsrc, const int kt, const int nt, f32x4 (&v)[4], bool& ok) {
    const int tid = otid(); const int c4 = tid & 31, kr = tid >> 5; const int R = nt * 128 + c4 * 4; const float* s = s0; int col = R; ok = R < Nsrc;
    if (mode != 0) { s = ((R >> 7) & 1) ? s1 : s0; col = (R >> 8) * 128 + (R & 127); ok = true; }
    if (!ok) col = 0;
    const float* sp = s + (size_t)(kt * 64 + kr) * Nsrc + col;
#pragma unroll
    for (int p = 0; p < 4; ++p) v[p] = *(const f32x4*)(sp + (size_t)p * 16 * Nsrc);
}
__device__ __forceinline__ void tt_to_lds(const f32x4 (&v)[4], const bool ok, LAS float* tile) {
    const int tid = otid(); const int c4 = tid & 31, kr = tid >> 5;
#pragma unroll
    for (int p = 0; p < 4; ++p) *(LAS f32x4*)(tile + (p * 16 + kr) * 132 + c4 * 4) = ok ? v[p] : (f32x4){0.f, 0.f, 0.f, 0.f};
}
__device__ __forceinline__ void tt_store(bf16_t* dst, const int K, const int kt, const int nt, LAS float* tile) {
    const int tid = otid(); const int R = tid >> 2, kq = tid & 3; float v[16];
#pragma unroll
    for (int i = 0; i < 16; ++i) v[i] = tile[(kq * 16 + i) * 132 + R];
    bf16_t* d = dst + (size_t)(nt * 128 + R) * K + kt * 64 + kq * 16;
    *(bf16x8*)d = pack8(v[0], v[1], v[2], v[3], v[4], v[5], v[6], v[7]);
    *(bf16x8*)(d + 8) = pack8(v[8], v[9], v[10], v[11], v[12], v[13], v[14], v[15]);
}

__device__ __forceinline__ void rmsnorm_rows(const float* __restrict__ x, const float* __restrict__ g, bf16_t* __restrict__ out) {
    const int lane = otid() & 63, wave = otid() >> 6;
    f32x4 gq[8];
#pragma unroll
    for (int j = 0; j < 8; ++j) gq[j] = *(const f32x4*)(g + (j * 64 + lane) * 4);
    for (int row = (blockIdx.x * 8 + wave) * 2; row < MROWS; row += gridDim.x * 16) {
        f32x4 v[2][8]; float ss[2] = {0.f, 0.f};
#pragma unroll
        for (int q = 0; q < 2; ++q)
#pragma unroll
            for (int j = 0; j < 8; ++j) v[q][j] = *(const f32x4*)(x + (size_t)(row + q) * DM + (j * 64 + lane) * 4);
#pragma unroll
        for (int q = 0; q < 2; ++q) {
#pragma unroll
            for (int j = 0; j < 8; ++j) ss[q] += v[q][j][0] * v[q][j][0] + v[q][j][1] * v[q][j][1] + v[q][j][2] * v[q][j][2] + v[q][j][3] * v[q][j][3];
            ss[q] = wave_sum(ss[q]); const float rs = rsqrtf(ss[q] * (1.f / DM) + 1e-6f);
#pragma unroll
            for (int j = 0; j < 8; ++j) {
                const f32x4 gg = gq[j]; u32x2 w;
                w.x = cvt_pk_bf16(v[q][j][0] * rs * gg[0], v[q][j][1] * rs * gg[1]); w.y = cvt_pk_bf16(v[q][j][2] * rs * gg[2], v[q][j][3] * rs * gg[3]);
                *(u32x2*)(out + (size_t)(row + q) * DM + (j * 64 + lane) * 4) = w;
            }
        }
    }
}

#define TT_DECODE(it_, S0, S1, DST, MODE, KK, NS, KT, NTT) do { \
    constexpr int N0_ = 32 * 44, N1_ = 32 * 16, N2_ = 32 * 88; const int i_ = (it_); \
    if (i_ < N0_) { S0 = S1 = p.in[I_WIN] + (size_t)layer * DM * NIN; DST = (bf16_t*)(p.ws + WS_WIN); MODE = 0; KK = DM; NS = NIN; KT = i_ / 44; NTT = i_ % 44; } \
    else if (i_ < N0_ + N1_) { const int j_ = i_ - N0_; S0 = S1 = p.in[I_WOUT] + (size_t)layer * DM * DM; DST = (bf16_t*)(p.ws + WS_WOUT); MODE = 0; KK = DM; NS = DM; KT = j_ / 16; NTT = j_ % 16; } \
    else if (i_ < N0_ + N1_ + N2_) { const int j_ = i_ - N0_ - N1_; S0 = p.in[I_WG] + (size_t)layer * DM * DFF; S1 = p.in[I_WU] + (size_t)layer * DM * DFF; DST = (bf16_t*)(p.ws + WS_WGU); MODE = 1; KK = DM; NS = DFF; KT = j_ / 88; NTT = j_ % 88; } \
    else { const int j_ = i_ - N0_ - N1_ - N2_; S0 = S1 = p.in[I_WD] + (size_t)layer * DFF * DM; DST = (bf16_t*)(p.ws + WS_WDN); MODE = 0; KK = DFF; NS = DM; KT = j_ / 16; NTT = j_ % 16; } } while (0)
__device__ __forceinline__ void phase_weights(const Params& p, const int layer, LAS unsigned char* lds) {
    LAS float* tile = (LAS float*)lds;
    constexpr int NT = 32 * 44;
    int Gs = gridDim.x; asm volatile("" : "+s"(Gs));
    int it = blockIdx.x; if (it >= NT) return;
    f32x4 v[4]; bool ok;
    { const float* s0; const float* s1; bf16_t* dst; int mode, K, Ns, kt, nt; TT_DECODE(it, s0, s1, dst, mode, K, Ns, kt, nt); tt_load(s0, s1, mode, Ns, kt, nt, v, ok); (void)dst; (void)K; }
    for (;;) {
        tt_to_lds(v, ok, tile);
        __syncthreads();
        const int itn = it + Gs; const bool more = itn < NT;
        if (more) { const float* s0; const float* s1; bf16_t* dst; int mode, K, Ns, kt, nt; TT_DECODE(itn, s0, s1, dst, mode, K, Ns, kt, nt); tt_load(s0, s1, mode, Ns, kt, nt, v, ok); (void)dst; (void)K; }
        { const float* s0; const float* s1; bf16_t* dst; int mode, K, Ns, kt, nt; TT_DECODE(it, s0, s1, dst, mode, K, Ns, kt, nt); tt_store(dst, K, kt, nt, tile); (void)s0; (void)s1; (void)mode; (void)Ns; }
        __syncthreads();
        if (!more) break;
        it = itn;
    }
}
__device__ __forceinline__ void weights_queue(const Params& p, const int layer, LAS unsigned char* lds, unsigned* ctr) {
    LAS float* tile = (LAS float*)lds; volatile LAS int* slot = (volatile LAS int*)(lds + 64 * 132 * 4);
    constexpr int T0 = 32 * 44, NT = 32 * 44 + 32 * 16 + 32 * 88 + 88 * 16, CH = 8;
    for (;;) {
        if (otid() == 0) slot[0] = T0 + CH * (int)__hip_atomic_fetch_add(ctr, 1u, __ATOMIC_RELAXED, __HIP_MEMORY_SCOPE_AGENT);
        __syncthreads();
        const int base = slot[0];
        if (base >= NT) break;
        const int end = base + CH < NT ? base + CH : NT;
        f32x4 v[4]; bool ok;
        { const float* s0; const float* s1; bf16_t* dst; int mode, K, Ns, kt, nt; TT_DECODE(base, s0, s1, dst, mode, K, Ns, kt, nt); tt_load(s0, s1, mode, Ns, kt, nt, v, ok); (void)dst; (void)K; }
        for (int it = base; it < end; ++it) {
            tt_to_lds(v, ok, tile);
            __syncthreads();
            if (it + 1 < end) { const float* s0; const float* s1; bf16_t* dst; int mode, K, Ns, kt, nt; TT_DECODE(it + 1, s0, s1, dst, mode, K, Ns, kt, nt); tt_load(s0, s1, mode, Ns, kt, nt, v, ok); (void)dst; (void)K; }
            { const float* s0; const float* s1; bf16_t* dst; int mode, K, Ns, kt, nt; TT_DECODE(it, s0, s1, dst, mode, K, Ns, kt, nt); tt_store(dst, K, kt, nt, tile); (void)s0; (void)s1; (void)mode; (void)Ns; }
            __syncthreads();
        }
    }
    __syncthreads();
}
__device__ __forceinline__ void store_vt16(bf16_t* dst, const float (&v)[16]) {
    u32x4 w0, w1;
    w0.x = cvt_pk_bf16(v[0], v[1]); w0.y = cvt_pk_bf16(v[2], v[3]); w0.z = cvt_pk_bf16(v[8], v[9]); w0.w = cvt_pk_bf16(v[10], v[11]);
    w1.x = cvt_pk_bf16(v[4], v[5]); w1.y = cvt_pk_bf16(v[6], v[7]); w1.z = cvt_pk_bf16(v[12], v[13]); w1.w = cvt_pk_bf16(v[14], v[15]);
    *(u32x4*)dst = w0; *(u32x4*)(dst + 8) = w1;
}

__device__ __forceinline__ void token_prep_unit(const Params& p, const int layer, const int u) {
    const int lane = otid() & 63, wave = otid() >> 6;
    const int row0 = u * 64 + (wave & 3) * 16; const int b = row0 >> 11, t16 = (row0 & 2047) >> 4;
    const bf16_t* proj = (const bf16_t*)(p.ws + WS_PROJ); float* mix = (float*)(p.ws + WS_MIX);
    if ((wave >> 2) == 0) {
        bf16_t* QN = (bf16_t*)(p.ws + WS_QN); bf16_t* KS = (bf16_t*)(p.ws + WS_KS); bf16_t* KW = (bf16_t*)(p.ws + WS_KW);
        const int d0 = (lane & 7) * 8;
        const f32x4 qg0 = *(const f32x4*)(p.in[I_QG] + layer * 64 + d0), qg1 = *(const f32x4*)(p.in[I_QG] + layer * 64 + d0 + 4);
        const f32x4 kg0 = *(const f32x4*)(p.in[I_KG] + layer * 64 + d0), kg1 = *(const f32x4*)(p.in[I_KG] + layer * 64 + d0 + 4);
        const float* cw = p.in[I_CONV] + (size_t)layer * 3 * 512 + lane * 8;
        const f32x4 c0a = *(const f32x4*)(cw), c0b = *(const f32x4*)(cw + 4), c1a = *(const f32x4*)(cw + 512), c1b = *(const f32x4*)(cw + 516), c2a = *(const f32x4*)(cw + 1024), c2b = *(const f32x4*)(cw + 1028);
        f32x4 z1a, z1b, z2a, z2b;
        if ((row0 & 2047) == 0) { z1a = z1b = z2a = z2b = (f32x4){0.f, 0.f, 0.f, 0.f}; }
        else {
            const bf16_t* P1 = proj + (size_t)(row0 - 1) * NPJ + lane * 8; const bf16_t* P2 = proj + (size_t)(row0 - 2) * NPJ + lane * 8;
            const u32x4 r1c = *(const u32x4*)(P1 + C_CG), r1h = *(const u32x4*)(P1 + C_BH), r2c = *(const u32x4*)(P2 + C_CG), r2h = *(const u32x4*)(P2 + C_BH);
            { const F8 c1 = up8(r1c), h1 = up8(r1h); z1a = c1.a * h1.a; z1b = c1.b * h1.b; }
            { const F8 c2 = up8(r2c), h2 = up8(r2h); z2a = c2.a * h2.a; z2b = c2.b * h2.b; }
        }
#pragma unroll 1
        for (int i0 = 0; i0 < 16; i0 += 4) {
            u32x4 rq[4], rk[4], rcg[4], rbh[4], rbg[4];
            const int l5 = lane & 31, sel = l5 >> 4, cc = (l5 & 15) * 8;
#pragma unroll
            for (int j = 0; j < 4; ++j) {
                const bf16_t* P = proj + (size_t)(row0 + i0 + j) * NPJ;
                rq[j] = *(const u32x4*)(P + lane * 8); rk[j] = *(const u32x4*)(P + (sel ? C_KW : C_KS) + cc);
                rcg[j] = *(const u32x4*)(P + lane * 8 + C_CG); rbh[j] = *(const u32x4*)(P + lane * 8 + C_BH); rbg[j] = *(const u32x4*)(P + lane * 8 + C_BG);
            }
#pragma unroll
            for (int j = 0; j < 4; ++j) {
                const int row = row0 + i0 + j;
                {
                    const F8 q8 = up8(rq[j]); const f32x4 a = q8.a, c = q8.b;
                    float ss = a[0] * a[0] + a[1] * a[1] + a[2] * a[2] + a[3] * a[3] + c[0] * c[0] + c[1] * c[1] + c[2] * c[2] + c[3] * c[3];
                    ss += __shfl_xor(ss, 1); ss += __shfl_xor(ss, 2); ss += __shfl_xor(ss, 4);
                    const float r = rsqrtf(ss * (1.f / 64.f) + 1e-6f); constexpr float QSC = 0.125f * 1.4426950408889634f;
                    *(bf16x8*)(QN + (size_t)row * 512 + lane * 8) = pack8(a[0] * r * qg0[0] * QSC, a[1] * r * qg0[1] * QSC, a[2] * r * qg0[2] * QSC, a[3] * r * qg0[3] * QSC,
                                                                           c[0] * r * qg1[0] * QSC, c[1] * r * qg1[1] * QSC, c[2] * r * qg1[2] * QSC, c[3] * r * qg1[3] * QSC);
                }
                {
                    const F8 k8 = up8(rk[j]); const f32x4 a = k8.a, c = k8.b;
                    float ss = a[0] * a[0] + a[1] * a[1] + a[2] * a[2] + a[3] * a[3] + c[0] * c[0] + c[1] * c[1] + c[2] * c[2] + c[3] * c[3];
                    ss += __shfl_xor(ss, 1); ss += __shfl_xor(ss, 2); ss += __shfl_xor(ss, 4);
                    const float r = rsqrtf(ss * (1.f / 64.f) + 1e-6f);
                    const int tk = row & 2047, gk = cc >> 6, dk = cc & 63;
                    if (lane < 32) *(bf16x8*)((sel ? KW : KS) + ((size_t)((b * 2 + gk) * 64 + (tk >> 5)) * 2048 + (size_t)((dk >> 4) * 64 + ((dk >> 3) & 1) * 32 + (tk & 31)) * 8)) =
                        pack8(a[0] * r * kg0[0], a[1] * r * kg0[1], a[2] * r * kg0[2], a[3] * r * kg0[3], c[0] * r * kg1[0], c[1] * r * kg1[1], c[2] * r * kg1[2], c[3] * r * kg1[3]);
                }
                {
                    const F8 cg8 = up8(rcg[j]), bh8 = up8(rbh[j]), bg8 = up8(rbg[j]);
                    const f32x4 za = cg8.a * bh8.a, zb = cg8.b * bh8.b;
                    const f32x4 ya = c0a * z2a + c1a * z1a + c2a * za, yb = c0b * z2b + c1b * z1b + c2b * zb;
                    *(f32x4*)(mix + (size_t)row * DM + 512 + lane * 8) = bg8.a * ya;
                    *(f32x4*)(mix + (size_t)row * DM + 512 + lane * 8 + 4) = bg8.b * yb;
                    z2a = z1a; z2b = z1b; z1a = za; z1b = zb;
                }
            }
        }
        {
            float v[4][16];
#pragma unroll
            for (int sel = 0; sel < 4; ++sel) {
                const int col = (sel < 2 ? C_VS : C_VW) + (sel & 1) * 64 + lane;
#pragma unroll
                for (int i = 0; i < 16; ++i) v[sel][i] = bf2f(proj[(size_t)(row0 + i) * NPJ + col]);
            }
#pragma unroll
            for (int sel = 0; sel < 4; ++sel)
                store_vt16((bf16_t*)(p.ws + (sel < 2 ? WS_VST : WS_VWT)) + ((size_t)((b * 2 + (sel & 1)) * 128 + t16) * 64 + lane) * 16, v[sel]);
        }
    } else {
        bf16_t* DQ = (bf16_t*)(p.ws + WS_DQ); bf16_t* DK = (bf16_t*)(p.ws + WS_DK); bf16_t* DVT = (bf16_t*)(p.ws + WS_DVT);
#pragma unroll 1
        for (int i0 = 0; i0 < 16; i0 += 8) {
            u32x4 rq[8], rk[8];
#pragma unroll
            for (int j = 0; j < 8; ++j) { const bf16_t* P = proj + (size_t)(row0 + i0 + j) * NPJ + lane * 8; rq[j] = *(const u32x4*)(P + C_DQ); rk[j] = *(const u32x4*)(P + C_DK); }
#pragma unroll
            for (int j = 0; j < 8; ++j) {
                const int row = row0 + i0 + j; const F8 q8 = up8(rq[j]); const f32x4 qa = q8.a, qb = q8.b;
                *(bf16x8*)(DQ + (size_t)row * 512 + lane * 8) = pack8(qa[0] * 0.125f, qa[1] * 0.125f, qa[2] * 0.125f, qa[3] * 0.125f, qb[0] * 0.125f, qb[1] * 0.125f, qb[2] * 0.125f, qb[3] * 0.125f);
                const int tk = row & 2047, hk = lane >> 3, dk = (lane & 7) * 8;
                *(u32x4*)(DK + ((size_t)((b * 8 + hk) * 64 + (tk >> 5)) * 2048 + (size_t)((dk >> 4) * 64 + ((dk >> 3) & 1) * 32 + (tk & 31)) * 8)) = rk[j];
            }
        }
#pragma unroll 1
        for (int h0 = 0; h0 < 8; h0 += 4) {
            float v[4][16];
#pragma unroll
            for (int hh = 0; hh < 4; ++hh)
#pragma unroll
                for (int i = 0; i < 16; ++i) v[hh][i] = bf2f(proj[(size_t)(row0 + i) * NPJ + C_DV + (h0 + hh) * 64 + lane]);
#pragma unroll
            for (int hh = 0; hh < 4; ++hh) store_vt16(DVT + ((size_t)((b * 8 + h0 + hh) * 128 + t16) * 64 + lane) * 16, v[hh]);
        }
    }
}

__device__ __forceinline__ void sgu_unit(const Params& p, const int layer, const int u, LAS unsigned char* lds) {
    const int lane = otid() & 63, wave = otid() >> 6;
    const int hh = u & 1, row0 = (u >> 1) * 128;
    const bf16_t* proj = (const bf16_t*)(p.ws + WS_PROJ); float* mix = (float*)(p.ws + WS_MIX);
    LAS bf16_t* vT = (LAS bf16_t*)lds;
    u32x4 rv[16];
#pragma unroll
    for (int i = 0; i < 16; ++i) rv[i] = *(const u32x4*)(proj + (size_t)(row0 + wave * 16 + i) * NPJ + C_CV + lane * 8);
#pragma unroll
    for (int i = 0; i < 16; ++i) {
        const int tk = wave * 16 + i;
        const F8 v8 = up8(rv[i]); const f32x4 a = v8.a, c = v8.b; float gv[8];
#pragma unroll
        for (int j = 0; j < 4; ++j) { gv[j] = gelu_tanh(a[j]); gv[4 + j] = gelu_tanh(c[j]); }
        float s = 0.f;
#pragma unroll
        for (int j = 0; j < 8; ++j) s += gv[j];
        s = wave_sum(s); const float mu = s * (1.f / 512.f); float q = 0.f;
#pragma unroll
        for (int j = 0; j < 8; ++j) { gv[j] -= mu; q += gv[j] * gv[j]; }
        q = wave_sum(q); const float rs = rsqrtf(q * (1.f / 512.f) + 1e-5f);
        if ((lane >> 5) == hh) {
            const int chl = (lane & 31) * 8;
#pragma unroll
            for (int j = 0; j < 8; ++j) vT[(chl + j) * 136 + tk] = bf1(gv[j] * rs);
        }
    }
    __syncthreads();
    const int hl = wave & 3, h = hh * 4 + hl, ph = wave >> 2, ql = lane & 31, hf = lane >> 5;
    const float* W = p.in[I_SGW] + (size_t)(layer * 8 + h) * 128 * 128;
    f32x16 acc[2][2];
#pragma unroll
    for (int a = 0; a < 2; ++a)
#pragma unroll
        for (int c = 0; c < 2; ++c)
#pragma unroll
            for (int r = 0; r < 16; ++r) acc[a][c][r] = 0.f;
#pragma unroll
    for (int ptl = 0; ptl < 2; ++ptl) {
        const int pt = ph * 2 + ptl, prow = pt * 32 + ql;
#pragma unroll 2
        for (int kc = 0; kc <= 2 * pt + 1; ++kc) {
            const int q0 = kc * 16 + hf * 8; const float* wp = W + (size_t)prow * 128 + q0;
            const f32x4 w0 = *(const f32x4*)(wp), w1 = *(const f32x4*)(wp + 4);
            const bf16x8 A = pack8(q0 + 0 <= prow ? w0[0] : 0.f, q0 + 1 <= prow ? w0[1] : 0.f, q0 + 2 <= prow ? w0[2] : 0.f, q0 + 3 <= prow ? w0[3] : 0.f,
                                   q0 + 4 <= prow ? w1[0] : 0.f, q0 + 5 <= prow ? w1[1] : 0.f, q0 + 6 <= prow ? w1[2] : 0.f, q0 + 7 <= prow ? w1[3] : 0.f);
#pragma unroll
            for (int et = 0; et < 2; ++et) {
                const bf16x8 Bv = *(const LAS bf16x8*)(vT + (hl * 64 + et * 32 + ql) * 136 + kc * 16 + hf * 8);
                acc[ptl][et] = mfma32(A, Bv, acc[ptl][et]);
            }
        }
    }
    const float* sb = p.in[I_SGB] + (size_t)(layer * 8 + h) * 128;
#pragma unroll
    for (int ptl = 0; ptl < 2; ++ptl) {
        bf16_t uraw[2][16];
#pragma unroll
        for (int et = 0; et < 2; ++et)
#pragma unroll
            for (int r = 0; r < 16; ++r) uraw[et][r] = proj[(size_t)(row0 + (ph * 2 + ptl) * 32 + (r & 3) + 8 * (r >> 2) + 4 * hf) * NPJ + C_CU + h * 64 + et * 32 + ql];
        float sbv[16];
#pragma unroll
        for (int r = 0; r < 16; ++r) sbv[r] = sb[(ph * 2 + ptl) * 32 + (r & 3) + 8 * (r >> 2) + 4 * hf];
#pragma unroll
        for (int et = 0; et < 2; ++et)
#pragma unroll
            for (int r = 0; r < 16; ++r) {
                const int pr = (ph * 2 + ptl) * 32 + (r & 3) + 8 * (r >> 2) + 4 * hf; const int col = h * 64 + et * 32 + ql;
                mix[(size_t)(row0 + pr) * DM + 1024 + col] = gelu_tanh(bf2f(uraw[et][r])) * (acc[ptl][et][r] + sbv[r]);
            }
    }
    __syncthreads();
}

__device__ __forceinline__ void compress_unit(const Params& p, const int layer, const int u, LAS unsigned char* lds) {
    const int tid = otid(), lane = tid & 63, wave = tid >> 6;
    const int combo = u >> 3, b = combo >> 2, g = (combo >> 1) & 1, kv = combo & 1, n0 = (u & 7) * 16;
    const bf16_t* proj = (const bf16_t*)(p.ws + WS_PROJ);
    LAS float* red = (LAS float*)lds; LAS float* hid = red + 8 * 17 * 64;
    const int colbase = (kv ? C_VC : C_KC) + g * 64;
    const float* W1 = p.in[I_CW1] + (size_t)(layer * 2 + kv) * 2048 * 64;
    const float* pos = p.in[I_CPOS] + (size_t)(layer * 2 + kv) * 2048;
    const int ql = lane & 31, hf = lane >> 5;
    f32x16 acc[2];
#pragma unroll
    for (int ct = 0; ct < 2; ++ct)
#pragma unroll
        for (int r = 0; r < 16; ++r) acc[ct][r] = 0.f;
#pragma unroll 2
    for (int st = 0; st < 16; ++st) {
        const int l = wave * 4 + (st >> 2), d0 = (st & 3) * 16 + hf * 8;
        bf16x8 A = {0, 0, 0, 0, 0, 0, 0, 0};
        if (ql < 16) { const int t = 16 * (n0 + ql) + l; if (t < T) A = *(const bf16x8*)(proj + (size_t)(b * T + t) * NPJ + colbase + d0); }
        else if (ql == 16) { const f32x4 p0 = *(const f32x4*)(pos + l * 64 + d0), p1 = *(const f32x4*)(pos + l * 64 + d0 + 4); A = pack8(p0[0], p0[1], p0[2], p0[3], p1[0], p1[1], p1[2], p1[3]); }
        const float* wp = W1 + (size_t)(l * 64 + d0) * 64 + ql;
#pragma unroll
        for (int ct = 0; ct < 2; ++ct) {
            float w[8];
#pragma unroll
            for (int j = 0; j < 8; ++j) w[j] = wp[j * 64 + ct * 32];
            acc[ct] = mfma32(A, pack8(w[0], w[1], w[2], w[3], w[4], w[5], w[6], w[7]), acc[ct]);
        }
    }
#pragma unroll
    for (int ct = 0; ct < 2; ++ct)
#pragma unroll
        for (int r = 0; r < 16; ++r) {
            const int row = (r & 3) + 8 * (r >> 2) + 4 * hf;
            if (row <= 16) red[(wave * 17 + row) * 64 + ct * 32 + ql] = acc[ct][r];
        }
    __syncthreads();
    for (int o = tid; o < 1024; o += 512) {
        const int r = o >> 6, cc = o & 63; float s = 0.f;
#pragma unroll
        for (int k = 0; k < 8; ++k) s += red[(k * 17 + r) * 64 + cc] + red[(k * 17 + 16) * 64 + cc];
        hid[o] = gelu_tanh(s);
    }
    __syncthreads();
    const float* W2 = p.in[I_CW2] + (size_t)(layer * 2 + kv) * 64 * 64;
    float w2c[64];
#pragma unroll
    for (int k = 0; k < 64; ++k) w2c[k] = W2[k * 64 + lane];
#pragma unroll
    for (int i = 0; i < 2; ++i) {
        const int r = wave + 8 * i; float s = 0.f;
#pragma unroll
        for (int k = 0; k < 64; k += 4) { const f32x4 hv = *(const LAS f32x4*)(hid + r * 64 + k); s += hv[0] * w2c[k] + hv[1] * w2c[k + 1] + hv[2] * w2c[k + 2] + hv[3] * w2c[k + 3]; }
        const int n = n0 + r;
        if (kv == 0) {
            const float ss = wave_sum(s * s); const float o = s * rsqrtf(ss * (1.f / 64.f) + 1e-6f) * p.in[I_KG][layer * 64 + lane];
            ((bf16_t*)(p.ws + WS_KCN))[(size_t)((b * 2 + g) * 4 + (n >> 5)) * 2048 + (size_t)((lane >> 4) * 64 + ((lane >> 3) & 1) * 32 + (n & 31)) * 8 + (lane & 7)] = bf1(o);
        } else {
            ((bf16_t*)(p.ws + WS_VCT))[(((size_t)(b * 2 + g) * 8 + (n >> 4)) * 64 + lane) * 16 + slot16(n & 15)] = bf1(s);
        }
    }
    __syncthreads();
}
__device__ __forceinline__ f32x16 st_tile(const bf16_t* __restrict__ kp  , const int ldk, const bf16x8 (&qf)[4], const int ql, const int hf) {
    f32x16 s;
#pragma unroll
    for (int r = 0; r < 16; ++r) s[r] = 0.f;
#pragma unroll
    for (int kk = 0; kk < 4; ++kk) { const bf16x8 kf = *(const bf16x8*)(kp + (size_t)ql * ldk + kk * 16 + hf * 8); s = mfma32(kf, qf[kk], s); }
    return s;
}
__device__ __forceinline__ void pv_tile(const bf16_t* __restrict__ vt, const f32x16& pm, f32x16 (&o)[2], const int ql, const int hf) {
#pragma unroll
    for (int kc = 0; kc < 2; ++kc) {
        const bf16x8 pb = pack8(pm[8 * kc + 0], pm[8 * kc + 1], pm[8 * kc + 2], pm[8 * kc + 3], pm[8 * kc + 4], pm[8 * kc + 5], pm[8 * kc + 6], pm[8 * kc + 7]);
#pragma unroll
        for (int dt = 0; dt < 2; ++dt) { const bf16x8 vf = *(const bf16x8*)(vt + ((size_t)(kc * 64 + dt * 32 + ql)) * 16 + hf * 8); o[dt] = mfma32(vf, pb, o[dt]); }
    }
}
__device__ __forceinline__ void osm_tile(f32x16& s, float& m, float& l, f32x16 (&o)[2], const bf16_t* __restrict__ vt, const int ql, const int hf) {
    float mx = s[0];
#pragma unroll
    for (int r = 1; r < 16; ++r) mx = fmaxf(mx, s[r]);
    mx = fmaxf(mx, __shfl_xor(mx, 32));
    const float mn = fmaxf(m, mx); const float alpha = __expf(m - mn); float ps = 0.f;
#pragma unroll
    for (int r = 0; r < 16; ++r) { const float pv = s[r] > -1e29f ? __expf(s[r] - mn) : 0.f; s[r] = pv; ps += pv; }
    l = l * alpha + ps; m = mn;
#pragma unroll
    for (int dt = 0; dt < 2; ++dt)
#pragma unroll
        for (int r = 0; r < 16; ++r) o[dt][r] *= alpha;
    pv_tile(vt, s, o, ql, hf);
}

#define LOADK4L(dst, kptr, ld) do { _Pragma("unroll") for (int kk_ = 0; kk_ < 4; ++kk_) dst[kk_] = *(const bf16x8*)((kptr) + (size_t)ql * (ld) + kk_ * 16 + hf * 8); } while (0)
#define LOADK4F(dst, tptr) do { _Pragma("unroll") for (int kk_ = 0; kk_ < 4; ++kk_) dst[kk_] = *(const bf16x8*)((tptr) + (size_t)(kk_ * 64 + hf * 32 + ql) * 8); } while (0)
#define PIN4(a) do { _Pragma("unroll") for (int i_ = 0; i_ < 4; ++i_) asm volatile("" : "+v"(a[i_])); } while (0)
#define COPY4(d, s_) do { _Pragma("unroll") for (int i_ = 0; i_ < 4; ++i_) d[i_] = s_[i_]; } while (0)
#define LOADV4(dst, vptr) do { _Pragma("unroll") for (int i_ = 0; i_ < 4; ++i_) dst[i_] = *(const bf16x8*)((vptr) + (size_t)(((i_ >> 1) * 64 + (i_ & 1) * 32 + ql) * 16 + hf * 8)); } while (0)
constexpr int TS_N = 2080, TW_N = 576, TBL_H = TS_N + TW_N, TBL_ALL = 8 * TBL_H;
constexpr float LOG2E = 1.4426950408889634f;
__device__ __forceinline__ float ex2(float x) { return __builtin_amdgcn_exp2f(x); }

__device__ __forceinline__ void cmp_unit(const Params& p, const int un, const LAS float* tbl, LAS float* impL  , LAS float* impT  ) {
    const int lane = otid() & 63, ql = lane & 31, hf = lane >> 5;
    const int bg = un & 15, qt = 63 - (un >> 4), b = bg >> 1, g = bg & 1, q0 = qt * 32, tq = q0 + ql; const size_t rowq = (size_t)b * T + tq;
    const bf16_t* proj = (const bf16_t*)(p.ws + WS_PROJ); float* mix = (float*)(p.ws + WS_MIX);
    const bf16_t* QN = (const bf16_t*)(p.ws + WS_QN);
    const bf16_t* Kc = (const bf16_t*)(p.ws + WS_KCN) + (size_t)(b * 2 + g) * 4 * 2048;
    const bf16_t* Vc = (const bf16_t*)(p.ws + WS_VCT) + (size_t)(b * 2 + g) * 8 * 64 * 16;
#pragma unroll
    for (int a = 0; a < 16; ++a) impL[a * 64 + lane] = 0.f;
    bf16_t graw[4];
#pragma unroll
    for (int r4 = 0; r4 < 4; ++r4) graw[r4] = proj[rowq * NPJ + C_AG + (g * 4 + r4) * 3 + 0];
    bf16x8 kA[4], kB[4], vA[4], vB[4];
    LOADK4F(kA, Kc); LOADK4F(kB, Kc + 2048); LOADV4(vA, Vc); LOADV4(vB, Vc + (size_t)2 * 1024);
    PIN4(kA); PIN4(kB); PIN4(vA); PIN4(vB);
    for (int r4 = 0; r4 < 4; ++r4) {
        const int hq = g * 4 + r4; const LAS float* bl = tbl + hq * TBL_H;
        bf16x8 qf[4];
#pragma unroll
        for (int kk = 0; kk < 4; ++kk) qf[kk] = *(const bf16x8*)(QN + rowq * 512 + hq * 64 + kk * 16 + hf * 8);
        float l = 0.f;
        f32x16 o[2];
#pragma unroll
        for (int dt = 0; dt < 2; ++dt)
#pragma unroll
            for (int r = 0; r < 16; ++r) o[dt][r] = 0.f;
        float prev_tile = 0.f;
#pragma unroll 1
        for (int pi = 0; pi < 2; ++pi) {
#pragma unroll
            for (int e = 0; e < 2; ++e) {
                const int kt = 2 * pi + e, ktn = (kt + 2) & 3;
                f32x16 s;
#pragma unroll
                for (int r = 0; r < 16; ++r) s[r] = 0.f;
                if (e == 0) {
#pragma unroll
                    for (int kk = 0; kk < 4; ++kk) s = mfma32(kA[kk], qf[kk], s);
                    LOADK4F(kA, Kc + (size_t)ktn * 2048);
                } else {
#pragma unroll
                    for (int kk = 0; kk < 4; ++kk) s = mfma32(kB[kk], qf[kk], s);
                    LOADK4F(kB, Kc + (size_t)ktn * 2048);
                }
                float ps = 0.f;
#pragma unroll
                for (int r = 0; r < 16; ++r) {
                    const int di = tq + 1 - 16 * (kt * 32 + (r & 3) + 8 * (r >> 2) + 4 * hf);
                    s[r] = ex2(s[r] + bl[di > 0 ? di : 0]); ps += s[r];
                }
                l += ps;
                float oth[4];
#pragma unroll
                for (int rg = 0; rg < 4; ++rg) oth[rg] = __shfl_xor(s[4 * rg + 3], 32);
#pragma unroll
                for (int rg = 0; rg < 4; ++rg) {
                    const float prev = hf ? oth[rg] : (rg > 0 ? oth[rg > 0 ? rg - 1 : 0] : prev_tile);
                    impT[(kt * 4 + rg) * 64 + lane] = s[4 * rg] + s[4 * rg + 1] + s[4 * rg + 2] + 0.5f * s[4 * rg + 3] + 0.5f * prev;
                }
                prev_tile = oth[3];
#pragma unroll
                for (int kc = 0; kc < 2; ++kc) {
                    const bf16x8 pb = pack8(s[8 * kc + 0], s[8 * kc + 1], s[8 * kc + 2], s[8 * kc + 3], s[8 * kc + 4], s[8 * kc + 5], s[8 * kc + 6], s[8 * kc + 7]);
#pragma unroll
                    for (int dt = 0; dt < 2; ++dt) o[dt] = mfma32(e == 0 ? vA[kc * 2 + dt] : vB[kc * 2 + dt], pb, o[dt]);
                }
                if (e == 0) LOADV4(vA, Vc + (size_t)(ktn * 2) * 1024); else LOADV4(vB, Vc + (size_t)(ktn * 2) * 1024);
            }
        }
        l += __shfl_xor(l, 32);
        const float inv = l > 0.f ? 1.f / l : 0.f;
#pragma unroll
        for (int a = 0; a < 16; ++a) impL[a * 64 + lane] += impT[a * 64 + lane] * inv;
#pragma unroll
        for (int dt = 0; dt < 2; ++dt)
#pragma unroll
            for (int r = 0; r < 16; ++r) o[dt][r] *= inv;
        const float g0 = sigmoidf_(bf2f(graw[r4]));
#pragma unroll
        for (int dt = 0; dt < 2; ++dt)
#pragma unroll
            for (int rg = 0; rg < 4; ++rg)
                *(f32x4*)(mix + rowq * DM + hq * 64 + dt * 32 + 8 * rg + 4 * hf) = (f32x4){o[dt][4 * rg] * g0, o[dt][4 * rg + 1] * g0, o[dt][4 * rg + 2] * g0, o[dt][4 * rg + 3] * g0};
    }
    {
        const int cur = tq >> 6; float own[16], oth[16];
#pragma unroll
        for (int a = 0; a < 16; ++a) {
            const int j = 2 * a + hf; const bool forced = (j == 0) || (j == cur) || (j == cur - 1);
            own[a] = j <= cur ? impL[a * 64 + lane] + (forced ? 1000.f : 0.f) : -1e30f;
        }
#pragma unroll
        for (int a = 0; a < 16; ++a) { oth[a] = __shfl_xor(own[a], 32); impL[a * 64 + lane] = own[a]; }
        unsigned bits = 0u;
#pragma unroll 1
        for (int a = 0; a < 16; ++a) {
            int rank = 0; const float y = impL[a * 64 + lane]; const int ao = hf ? a + 1 : a;
#pragma unroll
            for (int c = 0; c < 16; ++c) {
                rank += (own[c] > y || (own[c] == y && c < a)) ? 1 : 0;
                rank += (oth[c] > y || (oth[c] == y && c < ao)) ? 1 : 0;
            }
            const int j = 2 * a + hf;
            if (j <= cur && rank < 16) bits |= 1u << j;
        }
        const unsigned msk = bits | (unsigned)__shfl_xor((int)bits, 32);
        if (hf == 0) ((unsigned*)(p.ws + WS_MSK))[(size_t)(b * 2 + g) * T + tq] = msk;
    }
}

__device__ __forceinline__ void osm3_tile(f32x16& s, float& l, f32x16 (&o)[2], const bf16x8 (&vf)[4]) {
    float ps = 0.f;
#pragma unroll
    for (int r = 0; r < 16; ++r) { s[r] = ex2(s[r]); ps += s[r]; }
    l += ps;
#pragma unroll
    for (int kc = 0; kc < 2; ++kc) {
        const bf16x8 pb = pack8(s[8 * kc + 0], s[8 * kc + 1], s[8 * kc + 2], s[8 * kc + 3], s[8 * kc + 4], s[8 * kc + 5], s[8 * kc + 6], s[8 * kc + 7]);
#pragma unroll
        for (int dt = 0; dt < 2; ++dt) o[dt] = mfma32(vf[kc * 2 + dt], pb, o[dt]);
    }
}
__device__ __forceinline__ void slc_next(unsigned& U, int& j, int& sub, const int q0, const bool first) {
    if (!first) { if (j >= 32) return; if (sub == 0 && j * 64 + 32 <= q0 + 31) { sub = 1; return; } }
    sub = 0; if (U) { j = __builtin_ctz(U); U &= U - 1; } else j = 32;
}
__device__ __forceinline__ void ws_unit(const Params& p, const int b, const int hq, const int qt, const LAS float* tbl) {
    const int lane = otid() & 63, ql = lane & 31, hf = lane >> 5;
    const int g = hq >> 2, q0 = qt * 32, tq = q0 + ql; const size_t rowq = (size_t)b * T + tq;
    const bf16_t* proj = (const bf16_t*)(p.ws + WS_PROJ); float* mix = (float*)(p.ws + WS_MIX);
    const bf16_t* KSb = (const bf16_t*)(p.ws + WS_KS) + (size_t)(b * 2 + g) * 64 * 2048;
    const bf16_t* KWb = (const bf16_t*)(p.ws + WS_KW) + (size_t)(b * 2 + g) * 64 * 2048;
    const bf16_t* VSb = (const bf16_t*)(p.ws + WS_VST) + (size_t)(b * 2 + g) * 128 * 64 * 16;
    const bf16_t* VWb = (const bf16_t*)(p.ws + WS_VWT) + (size_t)(b * 2 + g) * 128 * 64 * 16;
    const LAS float* tS = tbl + hq * TBL_H; const LAS float* tW = tS + TS_N;
    const unsigned msk = ((const unsigned*)(p.ws + WS_MSK))[(size_t)(b * 2 + g) * T + tq];
    bf16x8 qf[4];
#pragma unroll
    for (int kk = 0; kk < 4; ++kk) qf[kk] = *(const bf16x8*)((const bf16_t*)(p.ws + WS_QN) + rowq * 512 + hq * 64 + kk * 16 + hf * 8);
    const float graw_s = bf2f(proj[rowq * NPJ + C_AG + hq * 3 + 1]), graw_w = bf2f(proj[rowq * NPJ + C_AG + hq * 3 + 2]);
    f32x16 o[2]; float l = 0.f;
#pragma unroll
    for (int dt = 0; dt < 2; ++dt)
#pragma unroll
        for (int r = 0; r < 16; ++r) o[dt][r] = 0.f;
    bf16x8 kA[4], kB[4], vA[4], vB[4];
    {
        const int ktlo = (q0 > 511 ? q0 - 511 : 0) >> 5;
        LOADK4F(kA, KWb + (size_t)ktlo * 2048); LOADV4(vA, VWb + (size_t)(ktlo * 2) * 1024);
        { const int t1 = ktlo < qt ? ktlo + 1 : qt; LOADK4F(kB, KWb + (size_t)t1 * 2048); LOADV4(vB, VWb + (size_t)(t1 * 2) * 1024); }
        PIN4(kA); PIN4(vA); PIN4(kB); PIN4(vB);
        for (int kt = ktlo; kt <= qt; kt += 2) {
            const int ka = kt + 2 < qt ? kt + 2 : qt, kb = kt + 3 < qt ? kt + 3 : qt;
            {
                f32x16 s;
#pragma unroll
                for (int r = 0; r < 16; ++r) s[r] = 0.f;
#pragma unroll
                for (int kk = 0; kk < 4; ++kk) s = mfma32(kA[kk], qf[kk], s);
                LOADK4F(kA, KWb + (size_t)ka * 2048);
                const LAS float* tb = tW + (tq - kt * 32 + 5 - 4 * hf);
#pragma unroll
                for (int r = 0; r < 16; ++r) s[r] += tb[27 - (r & 3) - 8 * (r >> 2)];
                osm3_tile(s, l, o, vA);
                LOADV4(vA, VWb + (size_t)(ka * 2) * 1024);
            }
            {
                const bool real = kt + 1 <= qt;
                f32x16 s;
#pragma unroll
                for (int r = 0; r < 16; ++r) s[r] = 0.f;
#pragma unroll
                for (int kk = 0; kk < 4; ++kk) s = mfma32(kB[kk], qf[kk], s);
                LOADK4F(kB, KWb + (size_t)kb * 2048);
                const LAS float* tb = real ? tW + (tq - (kt + 1) * 32 + 5 - 4 * hf) : tS;
#pragma unroll
                for (int r = 0; r < 16; ++r) s[r] += tb[27 - (r & 3) - 8 * (r >> 2)];
                osm3_tile(s, l, o, vB);
                LOADV4(vB, VWb + (size_t)(kb * 2) * 1024);
            }
        }
        const float lt = l + __shfl_xor(l, 32); const float sc = (lt > 0.f ? 1.f / lt : 0.f) * sigmoidf_(graw_w);
        f32x4 c[2][4];
#pragma unroll
        for (int dt = 0; dt < 2; ++dt)
#pragma unroll
            for (int rg = 0; rg < 4; ++rg) c[dt][rg] = *(const f32x4*)(mix + rowq * DM + hq * 64 + dt * 32 + 8 * rg + 4 * hf);
#pragma unroll
        for (int dt = 0; dt < 2; ++dt)
#pragma unroll
            for (int rg = 0; rg < 4; ++rg)
                *(f32x4*)(mix + rowq * DM + hq * 64 + dt * 32 + 8 * rg + 4 * hf) = (f32x4){c[dt][rg][0] + o[dt][4 * rg] * sc, c[dt][rg][1] + o[dt][4 * rg + 1] * sc, c[dt][rg][2] + o[dt][4 * rg + 2] * sc, c[dt][rg][3] + o[dt][4 * rg + 3] * sc};
    }
    {
        l = 0.f;
#pragma unroll
        for (int dt = 0; dt < 2; ++dt)
#pragma unroll
            for (int r = 0; r < 16; ++r) o[dt][r] = 0.f;
        unsigned U = msk;
#pragma unroll
        for (int off = 1; off < 32; off <<= 1) U |= (unsigned)__shfl_xor((int)U, off);
        U = (unsigned)__builtin_amdgcn_readfirstlane((int)U);
        int j0 = 32, s0 = 0; slc_next(U, j0, s0, q0, true);
        int j1 = j0, s1 = s0; slc_next(U, j1, s1, q0, false);
        int j2 = j1, s2 = s1; slc_next(U, j2, s2, q0, false);
        int j3 = j2, s3 = s2; slc_next(U, j3, s3, q0, false);
        if (j0 < 32) {
            const int ka = j0 * 64 + s0 * 32, kb = j1 < 32 ? j1 * 64 + s1 * 32 : ka;
            LOADK4F(kA, KSb + (size_t)(ka >> 5) * 2048); LOADV4(vA, VSb + (size_t)(ka >> 4) * 1024); LOADK4F(kB, KSb + (size_t)(kb >> 5) * 2048); LOADV4(vB, VSb + (size_t)(kb >> 4) * 1024);
            PIN4(kA); PIN4(vA); PIN4(kB); PIN4(vB);
        }
        while (j0 < 32) {
            const int k0 = j0 * 64 + s0 * 32, k1 = j1 * 64 + s1 * 32;
            const int k2 = j2 < 32 ? j2 * 64 + s2 * 32 : k0, k3 = j3 < 32 ? j3 * 64 + s3 * 32 : k0;
            {
                const float madd = ((msk >> j0) & 1u) ? 0.f : -1e30f;
                f32x16 s;
#pragma unroll
                for (int r = 0; r < 16; ++r) s[r] = madd;
#pragma unroll
                for (int kk = 0; kk < 4; ++kk) s = mfma32(kA[kk], qf[kk], s);
                LOADK4F(kA, KSb + (size_t)(k2 >> 5) * 2048);
                const LAS float* tb = tS + (tq - k0 + 5 - 4 * hf);
#pragma unroll
                for (int r = 0; r < 16; ++r) s[r] += tb[27 - (r & 3) - 8 * (r >> 2)];
                osm3_tile(s, l, o, vA);
                LOADV4(vA, VSb + (size_t)(k2 >> 4) * 1024);
            }
            {
                const bool real = j1 < 32;
                const float madd = (real && ((msk >> (j1 & 31)) & 1u)) ? 0.f : -1e30f;
                f32x16 s;
#pragma unroll
                for (int r = 0; r < 16; ++r) s[r] = madd;
#pragma unroll
                for (int kk = 0; kk < 4; ++kk) s = mfma32(kB[kk], qf[kk], s);
                LOADK4F(kB, KSb + (size_t)(k3 >> 5) * 2048);
                const LAS float* tb = real ? tS + (tq - k1 + 5 - 4 * hf) : tS;
#pragma unroll
                for (int r = 0; r < 16; ++r) s[r] += tb[27 - (r & 3) - 8 * (r >> 2)];
                osm3_tile(s, l, o, vB);
                LOADV4(vB, VSb + (size_t)(k3 >> 4) * 1024);
            }
            j0 = j2; s0 = s2; j1 = j3; s1 = s3;
            j2 = j3; s2 = s3; slc_next(U, j2, s2, q0, false);
            j3 = j2; s3 = s2; slc_next(U, j3, s3, q0, false);
        }
        const float lt = l + __shfl_xor(l, 32); const float sc = (lt > 0.f ? 1.f / lt : 0.f) * sigmoidf_(graw_s);
        f32x4 c[2][4];
#pragma unroll
        for (int dt = 0; dt < 2; ++dt)
#pragma unroll
            for (int rg = 0; rg < 4; ++rg) c[dt][rg] = *(const f32x4*)(mix + rowq * DM + hq * 64 + dt * 32 + 8 * rg + 4 * hf);
#pragma unroll
        for (int dt = 0; dt < 2; ++dt)
#pragma unroll
            for (int rg = 0; rg < 4; ++rg)
                *(f32x4*)(mix + rowq * DM + hq * 64 + dt * 32 + 8 * rg + 4 * hf) = (f32x4){c[dt][rg][0] + o[dt][4 * rg] * sc, c[dt][rg][1] + o[dt][4 * rg + 1] * sc, c[dt][rg][2] + o[dt][4 * rg + 2] * sc, c[dt][rg][3] + o[dt][4 * rg + 3] * sc};
    }
}

__device__ __forceinline__ void sb_unit(const Params& p, const int b, const int h, const int qt) {
    const int lane = otid() & 63, ql = lane & 31, hf = lane >> 5;
    const int q0 = qt * 32, tq = q0 + ql; const size_t rowq = (size_t)b * T + tq;
    float* mix = (float*)(p.ws + WS_MIX);
    const bf16_t* DQ = (const bf16_t*)(p.ws + WS_DQ);
    const bf16_t* DKb = (const bf16_t*)(p.ws + WS_DK) + (size_t)(b * 8 + h) * 64 * 2048;
    const bf16_t* DVb = (const bf16_t*)(p.ws + WS_DVT) + (size_t)(b * 8 + h) * 128 * 64 * 16;
    bf16x8 qf[4];
#pragma unroll
    for (int kk = 0; kk < 4; ++kk) qf[kk] = *(const bf16x8*)(DQ + rowq * 512 + h * 64 + kk * 16 + hf * 8);
    f32x16 o[2];
#pragma unroll
    for (int dt = 0; dt < 2; ++dt)
#pragma unroll
        for (int r = 0; r < 16; ++r) o[dt][r] = 0.f;
    float carry = 0.f;
    bf16x8 kA[4], kB[4], vA[4];
    LOADK4F(kA, DKb + (size_t)qt * 2048);
    PIN4(kA);
    for (int kt = qt; kt >= 0; --kt) {
        const int k0 = kt * 32, kp = kt > 0 ? kt - 1 : 0;
        LOADK4F(kB, DKb + (size_t)kp * 2048); LOADV4(vA, DVb + (size_t)(kt * 2) * 1024);
        f32x16 s;
#pragma unroll
        for (int r = 0; r < 16; ++r) s[r] = 0.f;
#pragma unroll
        for (int kk = 0; kk < 4; ++kk) s = mfma32(kA[kk], qf[kk], s);
        float lm[16];
#pragma unroll
        for (int r = 0; r < 16; ++r) {
            const int key = k0 + (r & 3) + 8 * (r >> 2) + 4 * hf; const bool valid = key < tq; const float z = s[r];
            const float sp = fmaxf(z, 0.f) + __logf(1.f + __expf(-fabsf(z)));
            lm[r] = valid ? -sp : 0.f; s[r] = valid ? z - sp : -1e30f;
        }
        float G[4], Go[4];
#pragma unroll
        for (int rg = 0; rg < 4; ++rg) { G[rg] = (lm[4 * rg] + lm[4 * rg + 1]) + (lm[4 * rg + 2] + lm[4 * rg + 3]); Go[rg] = __shfl_xor(G[rg], 32); }
        float after = carry;
#pragma unroll
        for (int rg = 3; rg >= 0; --rg) {
            float tail = after + (hf ? 0.f : Go[rg]);
#pragma unroll
            for (int j = 3; j >= 0; --j) { const int r = 4 * rg + j; const float a = s[r] > -1e29f ? __expf(s[r] + tail) : 0.f; tail += lm[r]; s[r] = a; }
            after += G[rg] + Go[rg];
        }
        carry = after;
#pragma unroll
        for (int kc = 0; kc < 2; ++kc) {
            const bf16x8 pb = pack8(s[8 * kc + 0], s[8 * kc + 1], s[8 * kc + 2], s[8 * kc + 3], s[8 * kc + 4], s[8 * kc + 5], s[8 * kc + 6], s[8 * kc + 7]);
#pragma unroll
            for (int dt = 0; dt < 2; ++dt) o[dt] = mfma32(vA[kc * 2 + dt], pb, o[dt]);
        }
        COPY4(kA, kB);
        if (__all(carry < -105.f ? 1 : 0)) break;
    }
#pragma unroll
    for (int dt = 0; dt < 2; ++dt)
#pragma unroll
        for (int rg = 0; rg < 4; ++rg)
            *(f32x4*)(mix + rowq * DM + 1536 + h * 64 + dt * 32 + 8 * rg + 4 * hf) = (f32x4){o[dt][4 * rg], o[dt][4 * rg + 1], o[dt][4 * rg + 2], o[dt][4 * rg + 3]};
}

__device__ __forceinline__ int rel_bucket_dev(const int n) {
    if (n < 16) return n;
    const float nf = (float)n;
    int large = 16 + (int)(logf(nf / 16.f) / 4.1588830833596715f * 16.f);
    return large < 31 ? large : 31;
}
#define XB_TMO      128
#define XB_XCNT(j)  (256  + 64 * (j))
#define XB_XSUB(j)  (1280 + 64 * (j))
#define XB_XGEN(j)  (2304 + 64 * (j))
#define XB_TOP      3328
#define XB_TOPGEN   3392
#define XCD_BAR_WORDS 3456
#define XB_SPIN_CAP (1u << 18)

__device__ __forceinline__ unsigned xb_ld(unsigned* p)              { return __hip_atomic_load(p, __ATOMIC_RELAXED, __HIP_MEMORY_SCOPE_AGENT); }
__device__ __forceinline__ unsigned xb_add(unsigned* p, unsigned v) { return __hip_atomic_fetch_add(p, v, __ATOMIC_RELAXED, __HIP_MEMORY_SCOPE_AGENT); }
__device__ __forceinline__ unsigned xb_xcc_id() { return (unsigned)__builtin_amdgcn_s_getreg((3 << 11) | 20) & 0xFu; }
#define XB_SPIN(cond, bar) do { unsigned _sp = 0; while (cond) { __builtin_amdgcn_s_sleep(1); \
    if ((++_sp & 255u) == 0u) { if (xb_ld(&(bar)[XB_TMO])) break; if (_sp > XB_SPIN_CAP) { atomicAdd(&(bar)[XB_TMO], 1u); break; } } } } while (0)

struct XcdBarrier {
    unsigned* bar; unsigned x;
    volatile LAS unsigned* st;
};

__device__ __forceinline__ XcdBarrier xcd_barrier_post(unsigned* bar, volatile LAS unsigned* st) {
    XcdBarrier b; b.bar = bar; b.x = xb_xcc_id(); b.st = st;
    if (threadIdx.x == 0) (void)xb_add(&bar[XB_XCNT(b.x)], 1u);
    return b;
}
__device__ __forceinline__ void xcd_barrier_complete(unsigned* bar, unsigned x, unsigned& nloc, unsigned& nx) {
    const unsigned G = gridDim.x * gridDim.y * gridDim.z;
    unsigned sum, cnt, mine, sp = 0u;
    for (;;) {
        sum = 0u; cnt = 0u; mine = 0u;
#pragma unroll
        for (unsigned j = 0; j < 16; ++j) { const unsigned c = xb_ld(&bar[XB_XCNT(j)]); sum += c; cnt += (c > 0u) ? 1u : 0u; mine = (j == x) ? c : mine; }
        if (sum == G) break;
        __builtin_amdgcn_s_sleep(1);
        if ((++sp & 255u) == 0u) { if (xb_ld(&bar[XB_TMO])) break; if (sp > XB_SPIN_CAP) { atomicAdd(&bar[XB_TMO], 1u); break; } }
    }
    nloc = mine > 0u ? mine : 1u; nx = cnt > 0u ? cnt : 1u;
}

__device__ __forceinline__ void xcd_barrier(const XcdBarrier& b) {
    asm volatile("s_waitcnt vmcnt(0)" ::: "memory");
    __syncthreads();
    if (threadIdx.x == 0) {
        unsigned* bar = b.bar;
        __builtin_amdgcn_s_waitcnt(0);
        unsigned nloc = b.st[0], nx = b.st[1];
        if (nloc == 0u) { xcd_barrier_complete(bar, b.x, nloc, nx); b.st[0] = nloc; b.st[1] = nx; }
        const unsigned old = xb_add(&bar[XB_XSUB(b.x)], 1u);
        const unsigned gen = old / nloc;
        if (old + 1u == (gen + 1u) * nloc) {
            __builtin_amdgcn_fence(__ATOMIC_RELEASE, "agent");
            asm volatile("s_waitcnt vmcnt(0)" ::: "memory");
            const unsigned og = xb_add(&bar[XB_TOP], 1u);
            const unsigned tg = og / nx;
            if (og + 1u == (tg + 1u) * nx) xb_add(&bar[XB_TOPGEN], 1u);
            else XB_SPIN(xb_ld(&bar[XB_TOPGEN]) == tg, bar);
            __builtin_amdgcn_fence(__ATOMIC_ACQUIRE, "agent");
            xb_add(&bar[XB_XGEN(b.x)], 1u);
            asm volatile("s_waitcnt vmcnt(0)" ::: "memory");
        } else {
            XB_SPIN(xb_ld(&bar[XB_XGEN(b.x)]) == gen, bar);
            __builtin_amdgcn_fence(__ATOMIC_ACQUIRE, "agent");
            asm volatile("s_waitcnt vmcnt(0)" ::: "memory");
        }
    }
    __syncthreads();
}

__device__ __forceinline__ void finalize_rows(const Params& p, const int layer) {
    const int lane = otid() & 63, wave = otid() >> 6;
    const float* mix = (const float*)(p.ws + WS_MIX); bf16_t* out = (bf16_t*)(p.ws + WS_ABUF); const float* gg = p.in[I_GG] + (size_t)layer * DM;
    f32x4 gav[4], gcv[4];
#pragma unroll
    for (int g = 0; g < 4; ++g) { gav[g] = *(const f32x4*)(gg + g * 512 + lane * 8); gcv[g] = *(const f32x4*)(gg + g * 512 + lane * 8 + 4); }
    for (int row = blockIdx.x * 8 + wave; row < MROWS; row += gridDim.x * 8) {
        f32x4 a[4], c[4];
#pragma unroll
        for (int g = 0; g < 4; ++g) { const float* src = mix + (size_t)row * DM + g * 512 + lane * 8; a[g] = *(const f32x4*)(src); c[g] = *(const f32x4*)(src + 4); }
#pragma unroll
        for (int g = 0; g < 4; ++g) {
            float ss = a[g][0] * a[g][0] + a[g][1] * a[g][1] + a[g][2] * a[g][2] + a[g][3] * a[g][3] + c[g][0] * c[g][0] + c[g][1] * c[g][1] + c[g][2] * c[g][2] + c[g][3] * c[g][3];
            ss = wave_sum(ss); const float r = rsqrtf(ss * (1.f / 512.f) + 1e-6f);
            const f32x4 ga = gav[g], gc = gcv[g];
            *(bf16x8*)(out + (size_t)row * DM + g * 512 + lane * 8) = pack8(a[g][0] * r * ga[0], a[g][1] * r * ga[1], a[g][2] * r * ga[2], a[g][3] * r * ga[3], c[g][0] * r * gc[0], c[g][1] * r * gc[1], c[g][2] * r * gc[2], c[g][3] * r * gc[3]);
        }
    }
}

__device__ __forceinline__ int q_grab(unsigned* ctr) {
    int v = 0; if ((otid() & 63) == 0) v = (int)__hip_atomic_fetch_add(ctr, 1u, __ATOMIC_RELAXED, __HIP_MEMORY_SCOPE_AGENT);
    return __builtin_amdgcn_readfirstlane(v);
}
#ifdef PROBE_SEQ
constexpr int PH_PER_LAYER = 10, N_PHASES = 4 * (sizeof((int[])PROBE_SEQ) / sizeof(int));
#else
constexpr int PH_PER_LAYER = 10, N_PHASES = 4 * PH_PER_LAYER;
#endif

__global__ void __launch_bounds__(512, 2) mk_fwd(Params p0) {
    extern __shared__ __attribute__((aligned(16))) unsigned char lds_raw[];
    LAS unsigned char* lds = (LAS unsigned char*)lds_raw;
    cg::grid_group grid = cg::this_grid();
    const int G = gridDim.x, blk = blockIdx.x;
    volatile LAS unsigned* xst = (volatile LAS unsigned*)(lds + LDS_BYTES - 16);
    { const int t0 = otid(); if (t0 < 4) xst[t0] = 0u; }
    __syncthreads();
    XcdBarrier xbar = xcd_barrier_post((unsigned*)(p0.ws + WS_BAR), xst);
    for (int ph = p0.ph_lo; ph < p0.ph_hi; ++ph) {
        if (ph == p0.ph_lo + 1) grid.sync();
        else if (ph > p0.ph_lo) xcd_barrier(xbar);
        Params p = p0;
        {
            typedef __attribute__((address_space(1))) unsigned char* gp_t;
            gp_t gws = (gp_t)p0.ws, gout = (gp_t)p0.out;
            asm volatile("" : "+s"(gws), "+s"(gout));
            p.ws = (unsigned char*)gws; p.out = (float*)gout;
        }
#define LAUNDER_IN(i) do { typedef __attribute__((address_space(1))) unsigned char* gp2_t; gp2_t gi_ = (gp2_t)p0.in[i]; asm volatile("" : "+s"(gi_)); p.in[i] = (const float*)gi_; } while (0)
        bf16_t* abuf = (bf16_t*)(p.ws + WS_ABUF);
#ifdef PROBE_SEQ
        constexpr int kSeq[] = PROBE_SEQ; constexpr int kSeqN = sizeof(kSeq) / sizeof(int);
        const int layer = ph / kSeqN; int sp = 0;
#pragma unroll
        for (int i = 0; i < kSeqN; ++i) if (ph % kSeqN == i) sp = kSeq[i];
#else
        const int layer = ph / PH_PER_LAYER, sp = ph % PH_PER_LAYER;
#endif
#ifdef REPEAT_SP
        for (int rep = 0; rep < ((sp == REPEAT_SP) ? 2 : 1); ++rep) {
        __syncthreads();
#endif
        if (sp == 0) {
            LAUNDER_IN(I_X); LAUNDER_IN(I_NMIX); LAUNDER_IN(I_WIN); LAUNDER_IN(I_WOUT); LAUNDER_IN(I_WG); LAUNDER_IN(I_WU); LAUNDER_IN(I_WD);
#ifndef SKIP_P0
            phase_weights(p, layer, lds);
            rmsnorm_rows(layer == 0 ? p.in[I_X] : p.out, p.in[I_NMIX] + (size_t)layer * DM, abuf);
#endif
        } else if (sp == 1) {
            pg8::Gemm g{abuf, (const bf16_t*)(p.ws + WS_WIN), MROWS, NPJ, DM}; pg8::StaticOrder S; S.init(MROWS, NPJ, G, blk);
            EpiF32 E{(bf16_t*)(p.ws + WS_PROJ), NPJ};
#ifndef SKIP_G1
            pg8::gemm_phase<EpiF32, pg8::StaticOrder, true, true>(lds, g, S, E);
            LAUNDER_IN(I_WOUT); LAUNDER_IN(I_WG); LAUNDER_IN(I_WU); LAUNDER_IN(I_WD);
            weights_queue(p, layer, lds, (unsigned*)(p.ws + WS_BAR + 16384 + 4096) + layer * 16);
#endif
        } else if (sp == 2) {
            LAUNDER_IN(I_QG); LAUNDER_IN(I_KG); LAUNDER_IN(I_CONV); LAUNDER_IN(I_SGW); LAUNDER_IN(I_SGB); LAUNDER_IN(I_CPOS); LAUNDER_IN(I_CW1); LAUNDER_IN(I_CW2); LAUNDER_IN(I_REL);
            for (int u = blk; u < 256; u += G) token_prep_unit(p, layer, u);
            for (int u = blk; u < 256; u += G) sgu_unit(p, layer, u, lds);
            for (int u = blk; u < 256; u += G) compress_unit(p, layer, u, lds);
            {
                const int tid = otid();
                if (blk == 0 && tid < 64) {
                    float gq = fabsf(p.in[I_QG][layer * 64 + tid]), gk = fabsf(p.in[I_KG][layer * 64 + tid]);
                    const float r0 = p.in[I_REL][tid], r1 = p.in[I_REL][tid + 64], r2 = p.in[I_REL][tid + 128], r3 = p.in[I_REL][tid + 192];
                    float bm = fmaxf(fmaxf(fabsf(r0), fabsf(r1)), fmaxf(fabsf(r2), fabsf(r3)));
#pragma unroll
                    for (int o = 1; o < 64; o <<= 1) { gq = fmaxf(gq, __shfl_xor(gq, o)); gk = fmaxf(gk, __shfl_xor(gk, o)); }
#pragma unroll
                    for (int o = 8; o < 64; o <<= 1) bm = fmaxf(bm, __shfl_xor(bm, o));
                    if (tid < 8) ((float*)(p.ws + WS_BAR + 16384 + 16384 - 64))[tid] = fminf(64.f * 0.125f * LOG2E * gq * gk + bm * LOG2E, 60.f);
                }
            }
        } else if (sp == 3) {
            LAUNDER_IN(I_REL);
            const int tid = otid(), wave = __builtin_amdgcn_readfirstlane(tid >> 6);
            LAS float* tbl = (LAS float*)lds; const float* m0g = (const float*)(p.ws + WS_BAR + 16384 + 16384 - 64);
            for (int idx = tid; idx < TBL_ALL; idx += 512) {
                const int h = idx / TBL_H, i = idx - h * TBL_H; const bool isS = i < TS_N; const int dist = (isS ? i : i - TS_N) - 32;
                const bool ok = dist >= 0 && (isS || dist < 512);
                tbl[idx] = ok ? p.in[I_REL][rel_bucket_dev(dist) * 8 + h] * LOG2E - m0g[h] : -1e30f;
            }
            __syncthreads();
            const int gw = wave * G + blk, NW = 8 * G;
            if (NW >= 2048 && (G & 7) == 0) {
                if (gw < 1024) {
#ifndef SKIP_NSA
                    cmp_unit(p, gw, tbl, tbl + TBL_ALL + wave * 1024, tbl + TBL_ALL + 8192 + wave * 1024);
#endif
                }
                unsigned* ctr = (unsigned*)(p.ws + WS_BAR + 16384) + (layer * 8 + (blk & 7)) * 16;
                int u = q_grab(ctr);
                while (u < 512) {
                    const int un = q_grab(ctr);
#ifndef SKIP_SB
                    sb_unit(p, blk & 7, u & 7, 63 - (u >> 3));
#endif
                    u = un;
                }
            } else {
                for (int un = gw; un < 1024; un += NW) cmp_unit(p, un, tbl, tbl + TBL_ALL + wave * 1024, tbl + TBL_ALL + 8192 + wave * 1024);
                for (int ud = gw; ud < 4096; ud += NW) { const int bh = ud & 63; sb_unit(p, bh & 7, bh >> 3, 63 - (ud >> 6)); }
            }
        } else if (sp == 4) {
            const int tid = otid(), wave = __builtin_amdgcn_readfirstlane(tid >> 6);
            const LAS float* tbl = (const LAS float*)lds;
            if ((G & 7) == 0) {
                unsigned* ctr = (unsigned*)(p.ws + WS_BAR + 16384 + 8192) + (layer * 8 + (blk & 7)) * 16;
                volatile LAS int* slot = (volatile LAS int*)(lds + LDS_BYTES - 64);
                for (;;) {
                    if (otid() == 0) slot[0] = (int)__hip_atomic_fetch_add(ctr, 1u, __ATOMIC_RELAXED, __HIP_MEMORY_SCOPE_AGENT);
                    __syncthreads();
                    const int u = slot[0];
                    if (u >= 64) break;
#ifndef SKIP_WS
                    ws_unit(p, blk & 7, wave, 63 - u, tbl);
#endif
                    __syncthreads();
                }
            } else {
                const int gw = wave * G + blk, NW = 8 * G;
                for (int uu = gw; uu < 2048; uu += NW) {
                    const int bh = uu & 63, qa = uu >> 6;
                    ws_unit(p, bh & 7, bh >> 3, 63 - qa, tbl);
                    ws_unit(p, bh & 7, bh >> 3, qa, tbl);
                }
            }
        } else if (sp == 5) {
            LAUNDER_IN(I_GG);
#ifndef SKIP_FIN
            finalize_rows(p, layer);
#endif
        } else if (sp == 6) {
            LAUNDER_IN(I_X);
            pg8::Gemm g{abuf, (const bf16_t*)(p.ws + WS_WOUT), MROWS, DM, DM}; pg8::StaticOrder S; S.init(MROWS, DM, G, blk);
            EpiResid E{layer == 0 ? p.in[I_X] : p.out, p.out, DM};
#ifndef SKIP_G2
            pg8::gemm_phase<EpiResid, pg8::StaticOrder, true, true>(lds, g, S, E);
#endif
        } else if (sp == 7) {
            LAUNDER_IN(I_NFFN);
#ifndef SKIP_RN
            rmsnorm_rows(p.out, p.in[I_NFFN] + (size_t)layer * DM, abuf);
#endif
        } else if (sp == 8) {
            pg8::Gemm g{abuf, (const bf16_t*)(p.ws + WS_WGU), MROWS, NGU, DM}; pg8::StaticOrder S; S.init(MROWS, NGU, G, blk);
            EpiSwiglu E{(bf16_t*)(p.ws + WS_PROJ), DFF};
#ifndef SKIP_G3
            pg8::gemm_phase<EpiSwiglu, pg8::StaticOrder, true, true>(lds, g, S, E);
#endif
        } else {
            pg8::Gemm g{(const bf16_t*)(p.ws + WS_PROJ), (const bf16_t*)(p.ws + WS_WDN), MROWS, DM, DFF}; pg8::StaticOrder S; S.init(MROWS, DM, G, blk);
            EpiResid E{p.out, p.out, DM};
#ifndef SKIP_G2
            pg8::gemm_phase<EpiResid, pg8::StaticOrder, true, true>(lds, g, S, E);
#endif
        }
#ifdef REPEAT_SP
        }
#endif
    }
}

extern "C" void kernel_launch(void* const* d_in, const int* in_sizes, int n_in, void* d_out, int out_size, void* d_ws, size_t ws_size, hipStream_t stream) {
    static int grid_blocks = 0;
    if (!grid_blocks) {
        hipFuncSetAttribute((const void*)mk_fwd, hipFuncAttributeMaxDynamicSharedMemorySize, LDS_BYTES);
        int dev = 0, cus = 0, per_cu = 0;
        hipGetDevice(&dev);
        hipDeviceGetAttribute(&cus, hipDeviceAttributeMultiprocessorCount, dev);
        hipOccupancyMaxActiveBlocksPerMultiprocessor(&per_cu, mk_fwd, 512, LDS_BYTES);
        if (per_cu < 1) fprintf(stderr, "occupancy query returned %d\n", per_cu);
        grid_blocks = cus;
    }
    if (ws_size < WS_END) { fprintf(stderr, "workspace too small: %zu < %zu\n", ws_size, (size_t)WS_END); return; }
    Params p{};
    for (int i = 0; i < 18; ++i) p.in[i] = (const float*)d_in[i];
    p.out = (float*)d_out; p.ws = (unsigned char*)d_ws; p.ph_lo = 0; p.ph_hi = N_PHASES;
    void* args[] = {&p};
    (void)hipMemsetAsync((unsigned char*)d_ws + WS_BAR, 0, 32768, stream);
    hipError_t e = hipLaunchCooperativeKernel((void*)mk_fwd, dim3(grid_blocks), dim3(512), args, LDS_BYTES, stream);
    if (e != hipSuccess) fprintf(stderr, "cooperative launch failed: %s (grid %d)\n", hipGetErrorString(e), grid_blocks);
}
```

```cpp
#include <hip/hip_runtime.h>
#include <hip/hip_cooperative_groups.h>
#include <cstdio>
#include <cstdint>
namespace cg = cooperative_groups;
__device__ __forceinline__ int otid() { int t = threadIdx.x; asm volatile("" : "+v"(t)); return t; }
namespace pg8 {
#define PG8_LAS __attribute__((address_space(3)))
typedef unsigned short bf16_t;
typedef short bf16x8 __attribute__((ext_vector_type(8)));
typedef float f32x4 __attribute__((ext_vector_type(4)));
typedef unsigned u32x4 __attribute__((ext_vector_type(4)));
constexpr int BM = 256, BK = 64, HALF = 128, HTB = HALF * BK * 2  , STAGE_BYTES = 8 * HTB, NXCD = 8, WGM = 8;

__host__ __device__ __forceinline__ int lds_byte(int r, int c) { const int st = (r >> 4) * 2 + (c >> 5), rr = r & 15, cc = c & 31, ob = rr * 64 + cc * 2; return st * 1024 + (ob ^ (((ob >> 9) & 1) << 5)); }
__host__ __device__ __forceinline__ void stage_rc(int b, int& R, int& C) { const int st = b / 1024, sb = b % 1024, swz = sb ^ (((sb >> 9) & 1) << 5); R = (st >> 1) * 16 + swz / 64; C = (st & 1) * 32 + (swz % 64) / 2; }
__host__ __device__ __forceinline__ int perm32(int rho) { const int n = rho >> 4, i = rho & 15; return 8 * (i >> 2) + 4 * n + (i & 3); }

struct Unit { int pm, pn; };
struct Gemm { const bf16_t* A; const bf16_t* Bt; int M, N, K; };

struct StaticOrder {
    int nM, nN, nwg, G, c;
    __host__ __device__ void init(int M, int N, int G_, int c_) { nM = M / BM; nN = N / BM; nwg = nM * nN; G = G_; c = c_; }
    __host__ __device__ bool next(int i, Unit& u) const {
        const long L = (long)i * G + c; if (L >= nwg) return false;
        int wgid = (int)L; { const int q = nwg / NXCD, r = nwg % NXCD, xcd = wgid % NXCD, off = wgid / NXCD; wgid = (xcd < r ? xcd * (q + 1) : r * (q + 1) + (xcd - r) * q) + off; }
        const int nig = WGM * nN, gid = wgid / nig, fm = gid * WGM, gsz = (nM - fm) < WGM ? (nM - fm) : WGM;
        u.pm = fm + ((wgid % nig) % gsz); u.pn = (wgid % nig) / gsz; return true;
    }
    __device__ __forceinline__ void a_ready(const Unit&) const {}
    __device__ __forceinline__ void done(const Unit&) const {}
};

__device__ __forceinline__ unsigned cvt_pk_bf16(float lo, float hi) { unsigned r; asm volatile("v_cvt_pk_bf16_f32 %0, %1, %2" : "=v"(r) : "v"(lo), "v"(hi)); return r; }
template <class Epi, class Sched, bool ALIGN_EPI = false, bool SP2 = false>
__device__ __forceinline__ void gemm_phase(PG8_LAS unsigned char* lds, const Gemm g, const Sched& S, const Epi& E) {
    const int tid = otid(), wid = __builtin_amdgcn_readfirstlane(tid >> 6), lane = tid & 63, wr = wid >> 2, wc = wid & 3, fr = lane & 15, fq = lane >> 4;
    const int K = g.K, nt = K / BK;
    unsigned voffA[2], voffB[2];
#pragma unroll
    for (int i = 0; i < 2; ++i) { int R, C; stage_rc(tid * 16 + i * 8192, R, C); const int Rb = Epi::PERM ? ((R & ~31) + perm32(R & 31)) : R;
        voffA[i] = (unsigned)(R * K + C) * 2u; voffB[i] = (unsigned)(Rb * K + C) * 2u; }
    const size_t kstep = (size_t)(BK * 2);
    const size_t hstep = (size_t)HALF * K * 2;
    const size_t tstep = 2 * hstep;
    const unsigned ldsw = (unsigned)wid * 1024u;
    const int aoff = lds_byte(wr * 64 + fr, fq * 8), boff = lds_byte(wc * 32 + fr, fq * 8);
#define PG8_SA(b, h) (((b) * 2 + (h)) * HTB)
#define PG8_SB(b, h) ((4 + (b) * 2 + (h)) * HTB)
#define PG8_STAGE(bufoff, gbase, voff) do { _Pragma("unroll") for (int _i = 0; _i < 2; ++_i) \
        __builtin_amdgcn_global_load_lds((const unsigned*)((const char*)(gbase) + (voff)[_i]), (PG8_LAS unsigned*)(lds + (bufoff) + ldsw + _i * 8192), 16, 0, 0); } while (0)
#define PG8_LDA(dst, b, h) do { _Pragma("unroll") for (int m = 0; m < 4; ++m) _Pragma("unroll") for (int k = 0; k < 2; ++k) dst[m][k] = *(const PG8_LAS bf16x8*)(lds + PG8_SA(b, h) + aoff + m * 2048 + k * 1024); } while (0)
#define PG8_LDB(dst, b, h) do { _Pragma("unroll") for (int n = 0; n < 2; ++n) _Pragma("unroll") for (int k = 0; k < 2; ++k) dst[n][k] = *(const PG8_LAS bf16x8*)(lds + PG8_SB(b, h) + boff + n * 2048 + k * 1024); } while (0)
#define PG8_MMA(ai, bj, At, Bt) do { __builtin_amdgcn_s_setprio(1); _Pragma("unroll") for (int m = 0; m < 4; ++m) _Pragma("unroll") for (int n = 0; n < 2; ++n) _Pragma("unroll") for (int k = 0; k < 2; ++k) \
        acc[ai][bj][m][n] = __builtin_amdgcn_mfma_f32_16x16x32_bf16(Bt[n][k], At[m][k], acc[ai][bj][m][n], 0, 0, 0); __builtin_amdgcn_s_setprio(0); } while (0)
#define PG8_WAIT_V(n) asm volatile("s_waitcnt vmcnt(" #n ")" ::: "memory")
#define PG8_WAIT_L(n) asm volatile("s_waitcnt lgkmcnt(" #n ")" ::: "memory")
#define PG8_BAR __builtin_amdgcn_s_barrier()
#define PG8_SCHED __builtin_amdgcn_sched_barrier(0)
    Unit cur, nxt; int ui = 0;
    if (!S.next(0, cur)) return;
    f32x4 acc[2][2][4][2];
#pragma unroll
    for (int a = 0; a < 2; ++a)
#pragma unroll
        for (int b = 0; b < 2; ++b)
#pragma unroll
            for (int m = 0; m < 4; ++m)
#pragma unroll
                for (int n = 0; n < 2; ++n) acc[a][b][m][n] = (f32x4){0.f, 0.f, 0.f, 0.f};
    bf16x8 At[4][2], B0[2][2], B1[2][2];
    const char* cA = (const char*)g.A + (size_t)cur.pm * tstep; const char* cB = (const char*)g.Bt + (size_t)cur.pn * tstep;
    S.a_ready(cur);
    if constexpr (SP2) {
        PG8_STAGE(PG8_SB(0, 0), cB, voffB); PG8_STAGE(PG8_SB(0, 1), cB + hstep, voffB); PG8_STAGE(PG8_SA(0, 0), cA, voffA); PG8_STAGE(PG8_SA(0, 1), cA + hstep, voffA);
        if (wr == 1) PG8_BAR;
        PG8_WAIT_V(2); PG8_BAR;
        PG8_STAGE(PG8_SB(1, 0), cB + kstep, voffB); PG8_STAGE(PG8_SA(1, 0), cA + kstep, voffA); PG8_STAGE(PG8_SB(1, 1), cB + hstep + kstep, voffB);
        PG8_WAIT_V(6); PG8_BAR;
    } else {
        PG8_STAGE(PG8_SB(0, 0), cB, voffB); PG8_STAGE(PG8_SA(0, 0), cA, voffA); PG8_STAGE(PG8_SB(0, 1), cB + hstep, voffB); PG8_STAGE(PG8_SA(0, 1), cA + hstep, voffA);
        if (wr == 1) PG8_BAR;
        PG8_WAIT_V(4); PG8_BAR;
        PG8_STAGE(PG8_SB(1, 0), cB + kstep, voffB); PG8_STAGE(PG8_SA(1, 0), cA + kstep, voffA); PG8_STAGE(PG8_SB(1, 1), cB + hstep + kstep, voffB);
        PG8_WAIT_V(6); PG8_BAR;
    }
    for (;;) {
        const bool has_next = S.next(ui + 1, nxt);
        const char* nA = has_next ? (const char*)g.A + (size_t)nxt.pm * tstep : cA; const char* nB = has_next ? (const char*)g.Bt + (size_t)nxt.pn * tstep : cB;
        for (int t = 0; t < nt; t += 2) {
            const bool last = (t == nt - 2);
            const char* a1 = cA + (size_t)(t + 1) * kstep;
            const char* a2 = last ? nA : cA + (size_t)(t + 2) * kstep; const char* b2 = last ? nB : cB + (size_t)(t + 2) * kstep;
            const char* a3 = a2 + kstep; const char* b3 = b2 + kstep;
            if (last && has_next) S.a_ready(nxt);
            if constexpr (SP2) {
            PG8_LDB(B0, 0, 0); PG8_LDB(B1, 0, 1); PG8_SCHED; PG8_LDA(At, 0, 0); PG8_STAGE(PG8_SA(1, 1), a1 + hstep, voffA);
            PG8_WAIT_V(8); PG8_WAIT_L(0); PG8_BAR; PG8_MMA(0, 0, At, B0); PG8_MMA(0, 1, At, B1); PG8_BAR; PG8_SCHED;
            PG8_LDA(At, 0, 1); PG8_STAGE(PG8_SB(0, 0), b2, voffB); PG8_STAGE(PG8_SB(0, 1), b2 + hstep, voffB); PG8_STAGE(PG8_SA(0, 0), a2, voffA);
            PG8_WAIT_V(8); PG8_WAIT_L(0); PG8_BAR; PG8_MMA(1, 0, At, B0); PG8_MMA(1, 1, At, B1); PG8_BAR; PG8_SCHED;
            PG8_LDB(B0, 1, 0); PG8_LDB(B1, 1, 1); PG8_SCHED; PG8_LDA(At, 1, 0); PG8_STAGE(PG8_SA(0, 1), a2 + hstep, voffA);
            PG8_WAIT_V(8); PG8_WAIT_L(0); PG8_BAR; PG8_MMA(0, 0, At, B0); PG8_MMA(0, 1, At, B1); PG8_BAR; PG8_SCHED;
            PG8_LDA(At, 1, 1); PG8_STAGE(PG8_SB(1, 0), b3, voffB); PG8_STAGE(PG8_SB(1, 1), b3 + hstep, voffB); PG8_STAGE(PG8_SA(1, 0), a3, voffA);
            PG8_WAIT_V(8); PG8_WAIT_L(0); PG8_BAR; PG8_MMA(1, 0, At, B0); PG8_MMA(1, 1, At, B1); PG8_BAR; PG8_SCHED;
            } else {
            PG8_LDB(B0, 0, 0); PG8_SCHED; PG8_LDA(At, 0, 0); PG8_STAGE(PG8_SA(1, 1), a1 + hstep, voffA);
            PG8_WAIT_L(8); PG8_BAR; PG8_WAIT_L(0); PG8_MMA(0, 0, At, B0); PG8_BAR; PG8_SCHED;
            PG8_LDB(B1, 0, 1); PG8_STAGE(PG8_SB(0, 0), b2, voffB);
            PG8_BAR; PG8_WAIT_L(0); PG8_MMA(0, 1, At, B1); PG8_BAR;
            PG8_LDA(At, 0, 1); PG8_STAGE(PG8_SA(0, 0), a2, voffA);
            PG8_BAR; PG8_WAIT_L(0); PG8_MMA(1, 0, At, B0); PG8_BAR; PG8_SCHED;
            PG8_STAGE(PG8_SB(0, 1), b2 + hstep, voffB);
            PG8_WAIT_V(6); PG8_BAR; PG8_MMA(1, 1, At, B1); PG8_BAR;
            PG8_LDB(B0, 1, 0); PG8_SCHED; PG8_LDA(At, 1, 0); PG8_STAGE(PG8_SA(0, 1), a2 + hstep, voffA);
            PG8_WAIT_L(8); PG8_BAR; PG8_WAIT_L(0); PG8_MMA(0, 0, At, B0); PG8_BAR; PG8_SCHED;
            PG8_LDB(B1, 1, 1); PG8_STAGE(PG8_SB(1, 0), b3, voffB);
            PG8_BAR; PG8_WAIT_L(0); PG8_MMA(0, 1, At, B1); PG8_BAR;
            PG8_LDA(At, 1, 1); PG8_STAGE(PG8_SA(1, 0), a3, voffA);
            PG8_BAR; PG8_WAIT_L(0); PG8_MMA(1, 0, At, B0); PG8_BAR; PG8_SCHED;
            PG8_STAGE(PG8_SB(1, 1), b3 + hstep, voffB);
            PG8_WAIT_V(6); PG8_BAR; PG8_MMA(1, 1, At, B1); PG8_BAR;
            }
        }
        if constexpr (ALIGN_EPI) { if (wr == 0) PG8_BAR; }
        if constexpr (!Epi::AFTER_DRAIN) { E(acc, cur, wr, wc, fr, fq); S.done(cur); }
        if (!has_next) break;
#pragma unroll
        for (int a = 0; a < 2; ++a)
#pragma unroll
            for (int b = 0; b < 2; ++b)
#pragma unroll
                for (int m = 0; m < 4; ++m)
#pragma unroll
                    for (int n = 0; n < 2; ++n) acc[a][b][m][n] = (f32x4){0.f, 0.f, 0.f, 0.f};
        cur = nxt; cA = nA; cB = nB; ++ui;
        if constexpr (ALIGN_EPI) { if (wr == 1) PG8_BAR; }
    }
    PG8_WAIT_V(0);
    if constexpr (!ALIGN_EPI) { if (wr == 0) PG8_BAR; }
    PG8_BAR;
    if constexpr (Epi::AFTER_DRAIN) { E.fused(acc, cur, wr, wc, fr, fq, lds, wid, lane); S.done(cur); }
#undef PG8_SA
#undef PG8_SB
#undef PG8_STAGE
#undef PG8_LDA
#undef PG8_LDB
#undef PG8_MMA
#undef PG8_WAIT_V
#undef PG8_WAIT_L
#undef PG8_BAR
#undef PG8_SCHED
}
}
using pg8::bf16_t; using pg8::bf16x8; using pg8::f32x4; using pg8::u32x4; using pg8::cvt_pk_bf16;
typedef float f32x16 __attribute__((ext_vector_type(16)));
typedef unsigned u32x2 __attribute__((ext_vector_type(2)));
#define LAS __attribute__((address_space(3)))

constexpr int T = 2048, MROWS = 16384, DM = 2048, NPJ = 5632, DFF = 5632, NGU = 11264, NIN = 5400;
constexpr int C_KC = 512, C_VC = 640, C_KS = 768, C_VS = 896, C_KW = 1024, C_VW = 1152, C_AG = 1280, C_BG = 1304, C_CG = 1816, C_BH = 2328,
              C_CU = 2840, C_CV = 3352, C_DQ = 3864, C_DK = 4376, C_DV = 4888;
constexpr int LDS_BYTES = 159744;

constexpr size_t WS_WIN = 0;
constexpr size_t WS_WOUT = WS_WIN + (size_t)NPJ * DM * 2;
constexpr size_t WS_WGU = WS_WOUT + (size_t)DM * DM * 2;
constexpr size_t WS_WDN = WS_WGU + (size_t)NGU * DM * 2;
constexpr size_t WS_ABUF = WS_WDN + (size_t)DM * DFF * 2;
constexpr size_t WS_PROJ = WS_ABUF + (size_t)MROWS * DM * 2;
constexpr size_t WS_MIX = WS_PROJ + (size_t)MROWS * NPJ * 4;
constexpr size_t WS_QN = WS_MIX + (size_t)MROWS * DM * 4;
constexpr size_t WS_KS = WS_QN + (size_t)MROWS * 512 * 2;
constexpr size_t WS_KW = WS_KS + (size_t)MROWS * 128 * 2;
constexpr size_t WS_VST = WS_KW + (size_t)MROWS * 128 * 2;
constexpr size_t WS_VWT = WS_VST + (size_t)MROWS * 128 * 2;
constexpr size_t WS_KCN = WS_VWT + (size_t)MROWS * 128 * 2;
constexpr size_t WS_VCT = WS_KCN + (size_t)16 * 128 * 64 * 2;
constexpr size_t WS_DQ = WS_VCT + (size_t)16 * 128 * 64 * 2;
constexpr size_t WS_DK = WS_DQ + (size_t)MROWS * 512 * 2;
constexpr size_t WS_DVT = WS_DK + (size_t)MROWS * 512 * 2;
constexpr size_t WS_MSK = WS_DVT + (size_t)MROWS * 512 * 2;
constexpr size_t WS_BAR = WS_MSK + (size_t)16 * 2048 * 4;
constexpr size_t WS_END = WS_BAR + 32768;

struct Params { const float* in[18]; float* out; unsigned char* ws; int ph_lo, ph_hi; };
enum { I_X = 0, I_WIN, I_WOUT, I_NMIX, I_NFFN, I_QG, I_KG, I_CPOS, I_CW1, I_CW2, I_REL, I_CONV, I_SGW, I_SGB, I_GG, I_WG, I_WU, I_WD };

__device__ __forceinline__ float wave_sum(float v) {
#pragma unroll
    for (int o = 1; o < 64; o <<= 1) v += __shfl_xor(v, o);
    return v;
}
__device__ __forceinline__ float gelu_tanh(float x) {
    const float u = 0.7978845608028654f * (x + 0.044715f * x * x * x);
    const float e = __expf(2.f * u);
    const float th = 1.f - 2.f / (e + 1.f);
    return 0.5f * x * (1.f + th);
}
__device__ __forceinline__ float sigmoidf_(float x) { return 1.f / (1.f + __expf(-x)); }
__device__ __forceinline__ bf16x8 pack8(float a0, float a1, float a2, float a3, float a4, float a5, float a6, float a7) {
    u32x4 w; w.x = cvt_pk_bf16(a0, a1); w.y = cvt_pk_bf16(a2, a3); w.z = cvt_pk_bf16(a4, a5); w.w = cvt_pk_bf16(a6, a7);
    return __builtin_bit_cast(bf16x8, w);
}
__device__ __forceinline__ float bf2f(bf16_t b) { return __uint_as_float((unsigned)b << 16); }
__device__ __forceinline__ float bflo(unsigned u) { return __uint_as_float(u << 16); }
__device__ __forceinline__ float bfhi(unsigned u) { return __uint_as_float(u & 0xffff0000u); }
struct F8 { f32x4 a, b; };
__device__ __forceinline__ F8 ld8(const bf16_t* p) {
    const u32x4 w = *(const u32x4*)p; F8 r;
    r.a = (f32x4){bflo(w.x), bfhi(w.x), bflo(w.y), bfhi(w.y)}; r.b = (f32x4){bflo(w.z), bfhi(w.z), bflo(w.w), bfhi(w.w)}; return r;
}
__device__ __forceinline__ F8 up8(const u32x4 w) { F8 r; r.a = (f32x4){bflo(w.x), bfhi(w.x), bflo(w.y), bfhi(w.y)}; r.b = (f32x4){bflo(w.z), bfhi(w.z), bflo(w.w), bfhi(w.w)}; return r; }
__device__ __forceinline__ bf16_t bf1(float a) { return (bf16_t)(cvt_pk_bf16(a, 0.f) & 0xffffu); }
__device__ __forceinline__ f32x16 mfma32(bf16x8 a, bf16x8 b, f32x16 c) { return __builtin_amdgcn_mfma_f32_32x32x16_bf16(a, b, c, 0, 0, 0); }
__device__ __forceinline__ int slot16(int ko) { return ((ko >> 2) & 1) * 8 + (ko >> 3) * 4 + (ko & 3); }

struct EpiF32 {
    static constexpr bool PERM = true, AFTER_DRAIN = false; bf16_t* O; int ldc;
    __device__ __forceinline__ void operator()(const f32x4 (&acc)[2][2][4][2], const pg8::Unit& u, int wr, int wc, int fr, int fq) const {
#pragma unroll
        for (int ai = 0; ai < 2; ++ai)
#pragma unroll
            for (int m = 0; m < 4; ++m) {
                bf16_t* rp = O + (size_t)(u.pm * 256 + ai * 128 + wr * 64 + m * 16 + fr) * ldc + u.pn * 256 + wc * 32 + fq * 8;
#pragma unroll
                for (int bj = 0; bj < 2; ++bj) {
                    const f32x4 v0 = acc[ai][bj][m][0], v1 = acc[ai][bj][m][1]; u32x4 w;
                    w.x = cvt_pk_bf16(v0[0], v0[1]); w.y = cvt_pk_bf16(v0[2], v0[3]); w.z = cvt_pk_bf16(v1[0], v1[1]); w.w = cvt_pk_bf16(v1[2], v1[3]);
                    *(u32x4*)(rp + bj * 128) = w;
                }
            }
    }
};
struct EpiResid {
    static constexpr bool PERM = true, AFTER_DRAIN = false; const float* base; float* out; int ldc;
    __device__ __forceinline__ void operator()(const f32x4 (&acc)[2][2][4][2], const pg8::Unit& u, int wr, int wc, int fr, int fq) const {
        const size_t off0 = (size_t)(u.pm * 256 + wr * 64 + fr) * ldc + u.pn * 256 + wc * 32 + fq * 8;
        f32x4 cur[2][2], nxt[2][2];
#pragma unroll
        for (int bj = 0; bj < 2; ++bj) { cur[bj][0] = *(const f32x4*)(base + off0 + bj * 128); cur[bj][1] = *(const f32x4*)(base + off0 + bj * 128 + 4); }
#pragma unroll
        for (int idx = 0; idx < 8; ++idx) {
            const int ai = idx >> 2, m = idx & 3; const size_t off = off0 + (size_t)(ai * 128 + m * 16) * ldc;
            if (idx < 7) {
                const size_t offn = off0 + (size_t)(((idx + 1) >> 2) * 128 + ((idx + 1) & 3) * 16) * ldc;
#pragma unroll
                for (int bj = 0; bj < 2; ++bj) { nxt[bj][0] = *(const f32x4*)(base + offn + bj * 128); nxt[bj][1] = *(const f32x4*)(base + offn + bj * 128 + 4); }
            }
#pragma unroll
            for (int bj = 0; bj < 2; ++bj) { *(f32x4*)(out + off + bj * 128) = cur[bj][0] + acc[ai][bj][m][0]; *(f32x4*)(out + off + bj * 128 + 4) = cur[bj][1] + acc[ai][bj][m][1]; }
#pragma unroll
            for (int bj = 0; bj < 2; ++bj) { cur[bj][0] = nxt[bj][0]; cur[bj][1] = nxt[bj][1]; }
        }
    }
};
struct EpiSwiglu {
    static constexpr bool PERM = true, AFTER_DRAIN = false; bf16_t* O; int ldc;
    __device__ __forceinline__ void operator()(const f32x4 (&acc)[2][2][4][2], const pg8::Unit& u, int wr, int wc, int fr, int fq) const {
#pragma unroll
        for (int ai = 0; ai < 2; ++ai)
#pragma unroll
            for (int m = 0; m < 4; ++m) {
                bf16_t* rp = O + (size_t)(u.pm * 256 + ai * 128 + wr * 64 + m * 16 + fr) * ldc + u.pn * 128 + wc * 32 + fq * 8;
                float r[8];
#pragma unroll
                for (int n = 0; n < 2; ++n) {
                    const f32x4 g = acc[ai][0][m][n], uu = acc[ai][1][m][n];
#pragma unroll
                    for (int j = 0; j < 4; ++j) r[4 * n + j] = g[j] * __builtin_amdgcn_rcpf(1.f + __builtin_amdgcn_exp2f(g[j] * -1.4426950408889634f)) * uu[j];
                }
                *(bf16x8*)rp = pack8(r[0], r[1], r[2], r[3], r[4], r[5], r[6], r[7]);
            }
    }
};

__device__ __forceinline__ void tt_load(const float* s0, const float* s1, const int mode, const int Nsrc, const int kt, const int nt, f32x4 (&v)[4], bool& ok) {
    const int tid = otid(); const int c4 = tid & 31, kr = tid >> 5; const int R = nt * 128 + c4 * 4; const float* s = s0; int col = R; ok = R < Nsrc;
    if (mode != 0) { s = ((R >> 7) & 1) ? s1 : s0; col = (R >> 8) * 128 + (R & 127); ok = true; }
    if (!ok) col = 0;
    const float* sp = s + (size_t)(kt * 64 + kr) * Nsrc + col;
#pragma unroll
    for (int p = 0; p < 4; ++p) v[p] = *(const f32x4*)(sp + (size_t)p * 16 * Nsrc);
}
__device__ __forceinline__ void tt_to_lds(const f32x4 (&v)[4], const bool ok, LAS float* tile) {
    const int tid = otid(); const int c4 = tid & 31, kr = tid >> 5;
#pragma unroll
    for (int p = 0; p < 4; ++p) *(LAS f32x4*)(tile + (p * 16 + kr) * 132 + c4 * 4) = ok ? v[p] : (f32x4){0.f, 0.f, 0.f, 0.f};
}
__device__ __forceinline__ void tt_store(bf16_t* dst, const int K, const int kt, const int nt, LAS float* tile) {
    const int tid = otid(); const int R = tid >> 2, kq = tid & 3; float v[16];
#pragma unroll
    for (int i = 0; i < 16; ++i) v[i] = tile[(kq * 16 + i) * 132 + R];
    bf16_t* d = dst + (size_t)(nt * 128 + R) * K + kt * 64 + kq * 16;
    *(bf16x8*)d = pack8(v[0], v[1], v[2], v[3], v[4], v[5], v[6], v[7]);
    *(bf16x8*)(d + 8) = pack8(v[8], v[9], v[10], v[11], v[12], v[13], v[14], v[15]);
}

__device__ __forceinline__ void rmsnorm_rows(const float* __restrict__ x, const float* __restrict__ g, bf16_t* __restrict__ out) {
    const int lane = otid() & 63, wave = otid() >> 6;
    f32x4 gq[8];
#pragma unroll
    for (int j = 0; j < 8; ++j) gq[j] = *(const f32x4*)(g + (j * 64 + lane) * 4);
    for (int row = (blockIdx.x * 8 + wave) * 2; row < MROWS; row += gridDim.x * 16) {
        f32x4 v[2][8]; float ss[2] = {0.f, 0.f};
#pragma unroll
        for (int q = 0; q < 2; ++q)
#pragma unroll
            for (int j = 0; j < 8; ++j) v[q][j] = *(const f32x4*)(x + (size_t)(row + q) * DM + (j * 64 + lane) * 4);
#pragma unroll
        for (int q = 0; q < 2; ++q) {
#pragma unroll
            for (int j = 0; j < 8; ++j) ss[q] += v[q][j][0] * v[q][j][0] + v[q][j][1] * v[q][j][1] + v[q][j][2] * v[q][j][2] + v[q][j][3] * v[q][j][3];
            ss[q] = wave_sum(ss[q]); const float rs = rsqrtf(ss[q] * (1.f / DM) + 1e-6f);
#pragma unroll
            for (int j = 0; j < 8; ++j) {
                const f32x4 gg = gq[j]; u32x2 w;
                w.x = cvt_pk_bf16(v[q][j][0] * rs * gg[0], v[q][j][1] * rs * gg[1]); w.y = cvt_pk_bf16(v[q][j][2] * rs * gg[2], v[q][j][3] * rs * gg[3]);
                *(u32x2*)(out + (size_t)(row + q) * DM + (j * 64 + lane) * 4) = w;
            }
        }
    }
}

#define TT_DECODE(it_, S0, S1, DST, MODE, KK, NS, KT, NTT) do { \
    constexpr int N0_ = 32 * 44, N1_ = 32 * 16, N2_ = 32 * 88; const int i_ = (it_); \
    if (i_ < N0_) { S0 = S1 = p.in[I_WIN] + (size_t)layer * DM * NIN; DST = (bf16_t*)(p.ws + WS_WIN); MODE = 0; KK = DM; NS = NIN; KT = i_ / 44; NTT = i_ % 44; } \
    else if (i_ < N0_ + N1_) { const int j_ = i_ - N0_; S0 = S1 = p.in[I_WOUT] + (size_t)layer * DM * DM; DST = (bf16_t*)(p.ws + WS_WOUT); MODE = 0; KK = DM; NS = DM; KT = j_ / 16; NTT = j_ % 16; } \
    else if (i_ < N0_ + N1_ + N2_) { const int j_ = i_ - N0_ - N1_; S0 = p.in[I_WG] + (size_t)layer * DM * DFF; S1 = p.in[I_WU] + (size_t)layer * DM * DFF; DST = (bf16_t*)(p.ws + WS_WGU); MODE = 1; KK = DM; NS = DFF; KT = j_ / 88; NTT = j_ % 88; } \
    else { const int j_ = i_ - N0_ - N1_ - N2_; S0 = S1 = p.in[I_WD] + (size_t)layer * DFF * DM; DST = (bf16_t*)(p.ws + WS_WDN); MODE = 0; KK = DFF; NS = DM; KT = j_ / 16; NTT = j_ % 16; } } while (0)
__device__ __forceinline__ void phase_weights(const Params& p, const int layer, LAS unsigned char* lds) {
    LAS float* tile = (LAS float*)lds;
    constexpr int NT = 32 * 44;
    int Gs = gridDim.x; asm volatile("" : "+s"(Gs));
    int it = blockIdx.x; if (it >= NT) return;
    f32x4 v[4]; bool ok;
    { const float* s0; const float* s1; bf16_t* dst; int mode, K, Ns, kt, nt; TT_DECODE(it, s0, s1, dst, mode, K, Ns, kt, nt); tt_load(s0, s1, mode, Ns, kt, nt, v, ok); (void)dst; (void)K; }
    for (;;) {
        tt_to_lds(v, ok, tile);
        __syncthreads();
        const int itn = it + Gs; const bool more = itn < NT;
        if (more) { const float* s0; const float* s1; bf16_t* dst; int mode, K, Ns, kt, nt; TT_DECODE(itn, s0, s1, dst, mode, K, Ns, kt, nt); tt_load(s0, s1, mode, Ns, kt, nt, v, ok); (void)dst; (void)K; }
        { const float* s0; const float* s1; bf16_t* dst; int mode, K, Ns, kt, nt; TT_DECODE(it, s0, s1, dst, mode, K, Ns, kt, nt); tt_store(dst, K, kt, nt, tile); (void)s0; (void)s1; (void)mode; (void)Ns; }
        __syncthreads();
        if (!more) break;
        it = itn;
    }
}
__device__ __forceinline__ void weights_queue(const Params& p, const int layer, LAS unsigned char* lds, unsigned* ctr) {
    LAS float* tile = (LAS float*)lds; volatile LAS int* slot = (volatile LAS int*)(lds + 64 * 132 * 4);
    constexpr int T0 = 32 * 44, NT = 32 * 44 + 32 * 16 + 32 * 88 + 88 * 16, CH = 8;
    for (;;) {
        if (otid() == 0) slot[0] = T0 + CH * (int)__hip_atomic_fetch_add(ctr, 1u, __ATOMIC_RELAXED, __HIP_MEMORY_SCOPE_AGENT);
        __syncthreads();
        const int base = slot[0];
        if (base >= NT) break;
        const int end = base + CH < NT ? base + CH : NT;
        f32x4 v[4]; bool ok;
        { const float* s0; const float* s1; bf16_t* dst; int mode, K, Ns, kt, nt; TT_DECODE(base, s0, s1, dst, mode, K, Ns, kt, nt); tt_load(s0, s1, mode, Ns, kt, nt, v, ok); (void)dst; (void)K; }
        for (int it = base; it < end; ++it) {
            tt_to_lds(v, ok, tile);
            __syncthreads();
            if (it + 1 < end) { const float* s0; const float* s1; bf16_t* dst; int mode, K, Ns, kt, nt; TT_DECODE(it + 1, s0, s1, dst, mode, K, Ns, kt, nt); tt_load(s0, s1, mode, Ns, kt, nt, v, ok); (void)dst; (void)K; }
            { const float* s0; const float* s1; bf16_t* dst; int mode, K, Ns, kt, nt; TT_DECODE(it, s0, s1, dst, mode, K, Ns, kt, nt); tt_store(dst, K, kt, nt, tile); (void)s0; (void)s1; (void)mode; (void)Ns; }
            __syncthreads();
        }
    }
    __syncthreads();
}
__device__ __forceinline__ void store_vt16(bf16_t* dst, const float (&v)[16]) {
    u32x4 w0, w1;
    w0.x = cvt_pk_bf16(v[0], v[1]); w0.y = cvt_pk_bf16(v[2], v[3]); w0.z = cvt_pk_bf16(v[8], v[9]); w0.w = cvt_pk_bf16(v[10], v[11]);
    w1.x = cvt_pk_bf16(v[4], v[5]); w1.y = cvt_pk_bf16(v[6], v[7]); w1.z = cvt_pk_bf16(v[12], v[13]); w1.w = cvt_pk_bf16(v[14], v[15]);
    *(u32x4*)dst = w0; *(u32x4*)(dst + 8) = w1;
}

__device__ __forceinline__ void token_prep_unit(const Params& p, const int layer, const int u) {
    const int lane = otid() & 63, wave = otid() >> 6;
    const int row0 = u * 64 + (wave & 3) * 16; const int b = row0 >> 11, t16 = (row0 & 2047) >> 4;
    const bf16_t* proj = (const bf16_t*)(p.ws + WS_PROJ); float* mix = (float*)(p.ws + WS_MIX);
    if ((wave >> 2) == 0) {
        bf16_t* QN = (bf16_t*)(p.ws + WS_QN); bf16_t* KS = (bf16_t*)(p.ws + WS_KS); bf16_t* KW = (bf16_t*)(p.ws + WS_KW);
        const int d0 = (lane & 7) * 8;
        const f32x4 qg0 = *(const f32x4*)(p.in[I_QG] + layer * 64 + d0), qg1 = *(const f32x4*)(p.in[I_QG] + layer * 64 + d0 + 4);
        const f32x4 kg0 = *(const f32x4*)(p.in[I_KG] + layer * 64 + d0), kg1 = *(const f32x4*)(p.in[I_KG] + layer * 64 + d0 + 4);
        const float* cw = p.in[I_CONV] + (size_t)layer * 3 * 512 + lane * 8;
        const f32x4 c0a = *(const f32x4*)(cw), c0b = *(const f32x4*)(cw + 4), c1a = *(const f32x4*)(cw + 512), c1b = *(const f32x4*)(cw + 516), c2a = *(const f32x4*)(cw + 1024), c2b = *(const f32x4*)(cw + 1028);
        f32x4 z1a, z1b, z2a, z2b;
        if ((row0 & 2047) == 0) { z1a = z1b = z2a = z2b = (f32x4){0.f, 0.f, 0.f, 0.f}; }
        else {
            const bf16_t* P1 = proj + (size_t)(row0 - 1) * NPJ + lane * 8; const bf16_t* P2 = proj + (size_t)(row0 - 2) * NPJ + lane * 8;
            const u32x4 r1c = *(const u32x4*)(P1 + C_CG), r1h = *(const u32x4*)(P1 + C_BH), r2c = *(const u32x4*)(P2 + C_CG), r2h = *(const u32x4*)(P2 + C_BH);
            { const F8 c1 = up8(r1c), h1 = up8(r1h); z1a = c1.a * h1.a; z1b = c1.b * h1.b; }
            { const F8 c2 = up8(r2c), h2 = up8(r2h); z2a = c2.a * h2.a; z2b = c2.b * h2.b; }
        }
#pragma unroll 1
        for (int i0 = 0; i0 < 16; i0 += 4) {
            u32x4 rq[4], rk[4], rcg[4], rbh[4], rbg[4];
            const int l5 = lane & 31, sel = l5 >> 4, cc = (l5 & 15) * 8;
#pragma unroll
            for (int j = 0; j < 4; ++j) {
                const bf16_t* P = proj + (size_t)(row0 + i0 + j) * NPJ;
                rq[j] = *(const u32x4*)(P + lane * 8); rk[j] = *(const u32x4*)(P + (sel ? C_KW : C_KS) + cc);
                rcg[j] = *(const u32x4*)(P + lane * 8 + C_CG); rbh[j] = *(const u32x4*)(P + lane * 8 + C_BH); rbg[j] = *(const u32x4*)(P + lane * 8 + C_BG);
            }
#pragma unroll
            for (int j = 0; j < 4; ++j) {
                const int row = row0 + i0 + j;
                {
                    const F8 q8 = up8(rq[j]); const f32x4 a = q8.a, c = q8.b;
                    float ss = a[0] * a[0] + a[1] * a[1] + a[2] * a[2] + a[3] * a[3] + c[0] * c[0] + c[1] * c[1] + c[2] * c[2] + c[3] * c[3];
                    ss += __shfl_xor(ss, 1); ss += __shfl_xor(ss, 2); ss += __shfl_xor(ss, 4);
                    const float r = rsqrtf(ss * (1.f / 64.f) + 1e-6f); constexpr float QSC = 0.125f * 1.4426950408889634f;
                    *(bf16x8*)(QN + (size_t)row * 512 + lane * 8) = pack8(a[0] * r * qg0[0] * QSC, a[1] * r * qg0[1] * QSC, a[2] * r * qg0[2] * QSC, a[3] * r * qg0[3] * QSC,
                                                                           c[0] * r * qg1[0] * QSC, c[1] * r * qg1[1] * QSC, c[2] * r * qg1[2] * QSC, c[3] * r * qg1[3] * QSC);
                }
                {
                    const F8 k8 = up8(rk[j]); const f32x4 a = k8.a, c = k8.b;
                    float ss = a[0] * a[0] + a[1] * a[1] + a[2] * a[2] + a[3] * a[3] + c[0] * c[0] + c[1] * c[1] + c[2] * c[2] + c[3] * c[3];
                    ss += __shfl_xor(ss, 1); ss += __shfl_xor(ss, 2); ss += __shfl_xor(ss, 4);
                    const float r = rsqrtf(ss * (1.f / 64.f) + 1e-6f);
                    const int tk = row & 2047, gk = cc >> 6, dk = cc & 63;
                    if (lane < 32) *(bf16x8*)((sel ? KW : KS) + ((size_t)((b * 2 + gk) * 64 + (tk >> 5)) * 2048 + (size_t)((dk >> 4) * 64 + ((dk >> 3) & 1) * 32 + (tk & 31)) * 8)) =
                        pack8(a[0] * r * kg0[0], a[1] * r * kg0[1], a[2] * r * kg0[2], a[3] * r * kg0[3], c[0] * r * kg1[0], c[1] * r * kg1[1], c[2] * r * kg1[2], c[3] * r * kg1[3]);
                }
                {
                    const F8 cg8 = up8(rcg[j]), bh8 = up8(rbh[j]), bg8 = up8(rbg[j]);
                    const f32x4 za = cg8.a * bh8.a, zb = cg8.b * bh8.b;
                    const f32x4 ya = c0a * z2a + c1a * z1a + c2a * za, yb = c0b * z2b + c1b * z1b + c2b * zb;
                    *(f32x4*)(mix + (size_t)row * DM + 512 + lane * 8) = bg8.a * ya;
                    *(f32x4*)(mix + (size_t)row * DM + 512 + lane * 8 + 4) = bg8.b * yb;
                    z2a = z1a; z2b = z1b; z1a = za; z1b = zb;
                }
            }
        }
        {
            float v[4][16];
#pragma unroll
            for (int sel = 0; sel < 4; ++sel) {
                const int col = (sel < 2 ? C_VS : C_VW) + (sel & 1) * 64 + lane;
#pragma unroll
                for (int i = 0; i < 16; ++i) v[sel][i] = bf2f(proj[(size_t)(row0 + i) * NPJ + col]);
            }
#pragma unroll
            for (int sel = 0; sel < 4; ++sel)
                store_vt16((bf16_t*)(p.ws + (sel < 2 ? WS_VST : WS_VWT)) + ((size_t)((b * 2 + (sel & 1)) * 128 + t16) * 64 + lane) * 16, v[sel]);
        }
    } else {
        bf16_t* DQ = (bf16_t*)(p.ws + WS_DQ); bf16_t* DK = (bf16_t*)(p.ws + WS_DK); bf16_t* DVT = (bf16_t*)(p.ws + WS_DVT);
#pragma unroll 1
        for (int i0 = 0; i0 < 16; i0 += 8) {
            u32x4 rq[8], rk[8];
#pragma unroll
            for (int j = 0; j < 8; ++j) { const bf16_t* P = proj + (size_t)(row0 + i0 + j) * NPJ + lane * 8; rq[j] = *(const u32x4*)(P + C_DQ); rk[j] = *(const u32x4*)(P + C_DK); }
#pragma unroll
            for (int j = 0; j < 8; ++j) {
                const int row = row0 + i0 + j; const F8 q8 = up8(rq[j]); const f32x4 qa = q8.a, qb = q8.b;
                *(bf16x8*)(DQ + (size_t)row * 512 + lane * 8) = pack8(qa[0] * 0.125f, qa[1] * 0.125f, qa[2] * 0.125f, qa[3] * 0.125f, qb[0] * 0.125f, qb[1] * 0.125f, qb[2] * 0.125f, qb[3] * 0.125f);
                const int tk = row & 2047, hk = lane >> 3, dk = (lane & 7) * 8;
                *(u32x4*)(DK + ((size_t)((b * 8 + hk) * 64 + (tk >> 5)) * 2048 + (size_t)((dk >> 4) * 64 + ((dk >> 3) & 1) * 32 + (tk & 31)) * 8)) = rk[j];
            }
        }
#pragma unroll 1
        for (int h0 = 0; h0 < 8; h0 += 4) {
            float v[4][16];
#pragma unroll
            for (int hh = 0; hh < 4; ++hh)
#pragma unroll
                for (int i = 0; i < 16; ++i) v[hh][i] = bf2f(proj[(size_t)(row0 + i) * NPJ + C_DV + (h0 + hh) * 64 + lane]);
#pragma unroll
            for (int hh = 0; hh < 4; ++hh) store_vt16(DVT + ((size_t)((b * 8 + h0 + hh) * 128 + t16) * 64 + lane) * 16, v[hh]);
        }
    }
}

__device__ __forceinline__ void sgu_unit(const Params& p, const int layer, const int u, LAS unsigned char* lds) {
    const int lane = otid() & 63, wave = otid() >> 6;
    const int hh = u & 1, row0 = (u >> 1) * 128;
    const bf16_t* proj = (const bf16_t*)(p.ws + WS_PROJ); float* mix = (float*)(p.ws + WS_MIX);
    LAS bf16_t* vT = (LAS bf16_t*)lds;
    u32x4 rv[16];
#pragma unroll
    for (int i = 0; i < 16; ++i) rv[i] = *(const u32x4*)(proj + (size_t)(row0 + wave * 16 + i) * NPJ + C_CV + lane * 8);
#pragma unroll
    for (int i = 0; i < 16; ++i) {
        const int tk = wave * 16 + i;
        const F8 v8 = up8(rv[i]); const f32x4 a = v8.a, c = v8.b; float gv[8];
#pragma unroll
        for (int j = 0; j < 4; ++j) { gv[j] = gelu_tanh(a[j]); gv[4 + j] = gelu_tanh(c[j]); }
        float s = 0.f;
#pragma unroll
        for (int j = 0; j < 8; ++j) s += gv[j];
        s = wave_sum(s); const float mu = s * (1.f / 512.f); float q = 0.f;
#pragma unroll
        for (int j = 0; j < 8; ++j) { gv[j] -= mu; q += gv[j] * gv[j]; }
        q = wave_sum(q); const float rs = rsqrtf(q * (1.f / 512.f) + 1e-5f);
        if ((lane >> 5) == hh) {
            const int chl = (lane & 31) * 8;
#pragma unroll
            for (int j = 0; j < 8; ++j) vT[(chl + j) * 136 + tk] = bf1(gv[j] * rs);
        }
    }
    __syncthreads();
    const int hl = wave & 3, h = hh * 4 + hl, ph = wave >> 2, ql = lane & 31, hf = lane >> 5;
    const float* W = p.in[I_SGW] + (size_t)(layer * 8 + h) * 128 * 128;
    f32x16 acc[2][2];
#pragma unroll
    for (int a = 0; a < 2; ++a)
#pragma unroll
        for (int c = 0; c < 2; ++c)
#pragma unroll
            for (int r = 0; r < 16; ++r) acc[a][c][r] = 0.f;
#pragma unroll
    for (int ptl = 0; ptl < 2; ++ptl) {
        const int pt = ph * 2 + ptl, prow = pt * 32 + ql;
#pragma unroll 2
        for (int kc = 0; kc <= 2 * pt + 1; ++kc) {
            const int q0 = kc * 16 + hf * 8; const float* wp = W + (size_t)prow * 128 + q0;
            const f32x4 w0 = *(const f32x4*)(wp), w1 = *(const f32x4*)(wp + 4);
            const bf16x8 A = pack8(q0 + 0 <= prow ? w0[0] : 0.f, q0 + 1 <= prow ? w0[1] : 0.f, q0 + 2 <= prow ? w0[2] : 0.f, q0 + 3 <= prow ? w0[3] : 0.f,
                                   q0 + 4 <= prow ? w1[0] : 0.f, q0 + 5 <= prow ? w1[1] : 0.f, q0 + 6 <= prow ? w1[2] : 0.f, q0 + 7 <= prow ? w1[3] : 0.f);
#pragma unroll
            for (int et = 0; et < 2; ++et) {
                const bf16x8 Bv = *(const LAS bf16x8*)(vT + (hl * 64 + et * 32 + ql) * 136 + kc * 16 + hf * 8);
                acc[ptl][et] = mfma32(A, Bv, acc[ptl][et]);
            }
        }
    }
    const float* sb = p.in[I_SGB] + (size_t)(layer * 8 + h) * 128;
#pragma unroll
    for (int ptl = 0; ptl < 2; ++ptl) {
        bf16_t uraw[2][16];
#pragma unroll
        for (int et = 0; et < 2; ++et)
#pragma unroll
            for (int r = 0; r < 16; ++r) uraw[et][r] = proj[(size_t)(row0 + (ph * 2 + ptl) * 32 + (r & 3) + 8 * (r >> 2) + 4 * hf) * NPJ + C_CU + h * 64 + et * 32 + ql];
        float sbv[16];
#pragma unroll
        for (int r = 0; r < 16; ++r) sbv[r] = sb[(ph * 2 + ptl) * 32 + (r & 3) + 8 * (r >> 2) + 4 * hf];
#pragma unroll
        for (int et = 0; et < 2; ++et)
#pragma unroll
            for (int r = 0; r < 16; ++r) {
                const int pr = (ph * 2 + ptl) * 32 + (r & 3) + 8 * (r >> 2) + 4 * hf; const int col = h * 64 + et * 32 + ql;
                mix[(size_t)(row0 + pr) * DM + 1024 + col] = gelu_tanh(bf2f(uraw[et][r])) * (acc[ptl][et][r] + sbv[r]);
            }
    }
    __syncthreads();
}

__device__ __forceinline__ void compress_unit(const Params& p, const int layer, const int u, LAS unsigned char* lds) {
    const int tid = otid(), lane = tid & 63, wave = tid >> 6;
    const int combo = u >> 3, b = combo >> 2, g = (combo >> 1) & 1, kv = combo & 1, n0 = (u & 7) * 16;
    const bf16_t* proj = (const bf16_t*)(p.ws + WS_PROJ);
    LAS float* red = (LAS float*)lds; LAS float* hid = red + 8 * 17 * 64;
    const int colbase = (kv ? C_VC : C_KC) + g * 64;
    const float* W1 = p.in[I_CW1] + (size_t)(layer * 2 + kv) * 2048 * 64;
    const float* pos = p.in[I_CPOS] + (size_t)(layer * 2 + kv) * 2048;
    const int ql = lane & 31, hf = lane >> 5;
    f32x16 acc[2];
#pragma unroll
    for (int ct = 0; ct < 2; ++ct)
#pragma unroll
        for (int r = 0; r < 16; ++r) acc[ct][r] = 0.f;
#pragma unroll 2
    for (int st = 0; st < 16; ++st) {
        const int l = wave * 4 + (st >> 2), d0 = (st & 3) * 16 + hf * 8;
        bf16x8 A = {0, 0, 0, 0, 0, 0, 0, 0};
        if (ql < 16) { const int t = 16 * (n0 + ql) + l; if (t < T) A = *(const bf16x8*)(proj + (size_t)(b * T + t) * NPJ + colbase + d0); }
        else if (ql == 16) { const f32x4 p0 = *(const f32x4*)(pos + l * 64 + d0), p1 = *(const f32x4*)(pos + l * 64 + d0 + 4); A = pack8(p0[0], p0[1], p0[2], p0[3], p1[0], p1[1], p1[2], p1[3]); }
        const float* wp = W1 + (size_t)(l * 64 + d0) * 64 + ql;
#pragma unroll
        for (int ct = 0; ct < 2; ++ct) {
            float w[8];
#pragma unroll
            for (int j = 0; j < 8; ++j) w[j] = wp[j * 64 + ct * 32];
            acc[ct] = mfma32(A, pack8(w[0], w[1], w[2], w[3], w[4], w[5], w[6], w[7]), acc[ct]);
        }
    }
#pragma unroll
    for (int ct = 0; ct < 2; ++ct)
#pragma unroll
        for (int r = 0; r < 16; ++r) {
            const int row = (r & 3) + 8 * (r >> 2) + 4 * hf;
            if (row <= 16) red[(wave * 17 + row) * 64 + ct * 32 + ql] = acc[ct][r];
        }
    __syncthreads();
    for (int o = tid; o < 1024; o += 512) {
        const int r = o >> 6, cc = o & 63; float s = 0.f;
#pragma unroll
        for (int k = 0; k < 8; ++k) s += red[(k * 17 + r) * 64 + cc] + red[(k * 17 + 16) * 64 + cc];
        hid[o] = gelu_tanh(s);
    }
    __syncthreads();
    const float* W2 = p.in[I_CW2] + (size_t)(layer * 2 + kv) * 64 * 64;
    float w2c[64];
#pragma unroll
    for (int k = 0; k < 64; ++k) w2c[k] = W2[k * 64 + lane];
#pragma unroll
    for (int i = 0; i < 2; ++i) {
        const int r = wave + 8 * i; float s = 0.f;
#pragma unroll
        for (int k = 0; k < 64; k += 4) { const f32x4 hv = *(const LAS f32x4*)(hid + r * 64 + k); s += hv[0] * w2c[k] + hv[1] * w2c[k + 1] + hv[2] * w2c[k + 2] + hv[3] * w2c[k + 3]; }
        const int n = n0 + r;
        if (kv == 0) {
            const float ss = wave_sum(s * s); const float o = s * rsqrtf(ss * (1.f / 64.f) + 1e-6f) * p.in[I_KG][layer * 64 + lane];
            ((bf16_t*)(p.ws + WS_KCN))[(size_t)((b * 2 + g) * 4 + (n >> 5)) * 2048 + (size_t)((lane >> 4) * 64 + ((lane >> 3) & 1) * 32 + (n & 31)) * 8 + (lane & 7)] = bf1(o);
        } else {
            ((bf16_t*)(p.ws + WS_VCT))[(((size_t)(b * 2 + g) * 8 + (n >> 4)) * 64 + lane) * 16 + slot16(n & 15)] = bf1(s);
        }
    }
    __syncthreads();
}
__device__ __forceinline__ f32x16 st_tile(const bf16_t* __restrict__ kp  , const int ldk, const bf16x8 (&qf)[4], const int ql, const int hf) {
    f32x16 s;
#pragma unroll
    for (int r = 0; r < 16; ++r) s[r] = 0.f;
#pragma unroll
    for (int kk = 0; kk < 4; ++kk) { const bf16x8 kf = *(const bf16x8*)(kp + (size_t)ql * ldk + kk * 16 + hf * 8); s = mfma32(kf, qf[kk], s); }
    return s;
}
__device__ __forceinline__ void pv_tile(const bf16_t* __restrict__ vt, const f32x16& pm, f32x16 (&o)[2], const int ql, const int hf) {
#pragma unroll
    for (int kc = 0; kc < 2; ++kc) {
        const bf16x8 pb = pack8(pm[8 * kc + 0], pm[8 * kc + 1], pm[8 * kc + 2], pm[8 * kc + 3], pm[8 * kc + 4], pm[8 * kc + 5], pm[8 * kc + 6], pm[8 * kc + 7]);
#pragma unroll
        for (int dt = 0; dt < 2; ++dt) { const bf16x8 vf = *(const bf16x8*)(vt + ((size_t)(kc * 64 + dt * 32 + ql)) * 16 + hf * 8); o[dt] = mfma32(vf, pb, o[dt]); }
    }
}
__device__ __forceinline__ void osm_tile(f32x16& s, float& m, float& l, f32x16 (&o)[2], const bf16_t* __restrict__ vt, const int ql, const int hf) {
    float mx = s[0];
#pragma unroll
    for (int r = 1; r < 16; ++r) mx = fmaxf(mx, s[r]);
    mx = fmaxf(mx, __shfl_xor(mx, 32));
    const float mn = fmaxf(m, mx); const float alpha = __expf(m - mn); float ps = 0.f;
#pragma unroll
    for (int r = 0; r < 16; ++r) { const float pv = s[r] > -1e29f ? __expf(s[r] - mn) : 0.f; s[r] = pv; ps += pv; }
    l = l * alpha + ps; m = mn;
#pragma unroll
    for (int dt = 0; dt < 2; ++dt)
#pragma unroll
        for (int r = 0; r < 16; ++r) o[dt][r] *= alpha;
    pv_tile(vt, s, o, ql, hf);
}

#define LOADK4L(dst, kptr, ld) do { _Pragma("unroll") for (int kk_ = 0; kk_ < 4; ++kk_) dst[kk_] = *(const bf16x8*)((kptr) + (size_t)ql * (ld) + kk_ * 16 + hf * 8); } while (0)
#define LOADK4F(dst, tptr) do { _Pragma("unroll") for (int kk_ = 0; kk_ < 4; ++kk_) dst[kk_] = *(const bf16x8*)((tptr) + (size_t)(kk_ * 64 + hf * 32 + ql) * 8); } while (0)
#define PIN4(a) do { _Pragma("unroll") for (int i_ = 0; i_ < 4; ++i_) asm volatile("" : "+v"(a[i_])); } while (0)
#define COPY4(d, s_) do { _Pragma("unroll") for (int i_ = 0; i_ < 4; ++i_) d[i_] = s_[i_]; } while (0)
#define LOADV4(dst, vptr) do { _Pragma("unroll") for (int i_ = 0; i_ < 4; ++i_) dst[i_] = *(const bf16x8*)((vptr) + (size_t)(((i_ >> 1) * 64 + (i_ & 1) * 32 + ql) * 16 + hf * 8)); } while (0)
constexpr int TS_N = 2080, TW_N = 576, TBL_H = TS_N + TW_N, TBL_ALL = 8 * TBL_H;
constexpr float LOG2E = 1.4426950408889634f;
__device__ __forceinline__ float ex2(float x) { return __builtin_amdgcn_exp2f(x); }

__device__ __forceinline__ void cmp_unit(const Params& p, const int un, const LAS float* tbl, LAS float* impL  , LAS float* impT  ) {
    const int lane = otid() & 63, ql = lane & 31, hf = lane >> 5;
    const int bg = un & 15, qt = 63 - (un >> 4), b = bg >> 1, g = bg & 1, q0 = qt * 32, tq = q0 + ql; const size_t rowq = (size_t)b * T + tq;
    const bf16_t* proj = (const bf16_t*)(p.ws + WS_PROJ); float* mix = (float*)(p.ws + WS_MIX);
    const bf16_t* QN = (const bf16_t*)(p.ws + WS_QN);
    const bf16_t* Kc = (const bf16_t*)(p.ws + WS_KCN) + (size_t)(b * 2 + g) * 4 * 2048;
    const bf16_t* Vc = (const bf16_t*)(p.ws + WS_VCT) + (size_t)(b * 2 + g) * 8 * 64 * 16;
#pragma unroll
    for (int a = 0; a < 16; ++a) impL[a * 64 + lane] = 0.f;
    bf16_t graw[4];
#pragma unroll
    for (int r4 = 0; r4 < 4; ++r4) graw[r4] = proj[rowq * NPJ + C_AG + (g * 4 + r4) * 3 + 0];
    bf16x8 kA[4], kB[4], vA[4], vB[4];
    LOADK4F(kA, Kc); LOADK4F(kB, Kc + 2048); LOADV4(vA, Vc); LOADV4(vB, Vc + (size_t)2 * 1024);
    PIN4(kA); PIN4(kB); PIN4(vA); PIN4(vB);
    for (int r4 = 0; r4 < 4; ++r4) {
        const int hq = g * 4 + r4; const LAS float* bl = tbl + hq * TBL_H;
        bf16x8 qf[4];
#pragma unroll
        for (int kk = 0; kk < 4; ++kk) qf[kk] = *(const bf16x8*)(QN + rowq * 512 + hq * 64 + kk * 16 + hf * 8);
        float l = 0.f;
        f32x16 o[2];
#pragma unroll
        for (int dt = 0; dt < 2; ++dt)
#pragma unroll
            for (int r = 0; r < 16; ++r) o[dt][r] = 0.f;
        float prev_tile = 0.f;
#pragma unroll 1
        for (int pi = 0; pi < 2; ++pi) {
#pragma unroll
            for (int e = 0; e < 2; ++e) {
                const int kt = 2 * pi + e, ktn = (kt + 2) & 3;
                f32x16 s;
#pragma unroll
                for (int r = 0; r < 16; ++r) s[r] = 0.f;
                if (e == 0) {
#pragma unroll
                    for (int kk = 0; kk < 4; ++kk) s = mfma32(kA[kk], qf[kk], s);
                    LOADK4F(kA, Kc + (size_t)ktn * 2048);
                } else {
#pragma unroll
                    for (int kk = 0; kk < 4; ++kk) s = mfma32(kB[kk], qf[kk], s);
                    LOADK4F(kB, Kc + (size_t)ktn * 2048);
                }
                float ps = 0.f;
#pragma unroll
                for (int r = 0; r < 16; ++r) {
                    const int di = tq + 1 - 16 * (kt * 32 + (r & 3) + 8 * (r >> 2) + 4 * hf);
                    s[r] = ex2(s[r] + bl[di > 0 ? di : 0]); ps += s[r];
                }
                l += ps;
                float oth[4];
#pragma unroll
                for (int rg = 0; rg < 4; ++rg) oth[rg] = __shfl_xor(s[4 * rg + 3], 32);
#pragma unroll
                for (int rg = 0; rg < 4; ++rg) {
                    const float prev = hf ? oth[rg] : (rg > 0 ? oth[rg > 0 ? rg - 1 : 0] : prev_tile);
                    impT[(kt * 4 + rg) * 64 + lane] = s[4 * rg] + s[4 * rg + 1] + s[4 * rg + 2] + 0.5f * s[4 * rg + 3] + 0.5f * prev;
                }
                prev_tile = oth[3];
#pragma unroll
                for (int kc = 0; kc < 2; ++kc) {
                    const bf16x8 pb = pack8(s[8 * kc + 0], s[8 * kc + 1], s[8 * kc + 2], s[8 * kc + 3], s[8 * kc + 4], s[8 * kc + 5], s[8 * kc + 6], s[8 * kc + 7]);
#pragma unroll
                    for (int dt = 0; dt < 2; ++dt) o[dt] = mfma32(e == 0 ? vA[kc * 2 + dt] : vB[kc * 2 + dt], pb, o[dt]);
                }
                if (e == 0) LOADV4(vA, Vc + (size_t)(ktn * 2) * 1024); else LOADV4(vB, Vc + (size_t)(ktn * 2) * 1024);
            }
        }
        l += __shfl_xor(l, 32);
        const float inv = l > 0.f ? 1.f / l : 0.f;
#pragma unroll
        for (int a = 0; a < 16; ++a) impL[a * 64 + lane] += impT[a * 64 + lane] * inv;
#pragma unroll
        for (int dt = 0; dt < 2; ++dt)
#pragma unroll
            for (int r = 0; r < 16; ++r) o[dt][r] *= inv;
        const float g0 = sigmoidf_(bf2f(graw[r4]));
#pragma unroll
        for (int dt = 0; dt < 2; ++dt)
#pragma unroll
            for (int rg = 0; rg < 4; ++rg)
                *(f32x4*)(mix + rowq * DM + hq * 64 + dt * 32 + 8 * rg + 4 * hf) = (f32x4){o[dt][4 * rg] * g0, o[dt][4 * rg + 1] * g0, o[dt][4 * rg + 2] * g0, o[dt][4 * rg + 3] * g0};
    }
    {
        const int cur = tq >> 6; float own[16], oth[16];
#pragma unroll
        for (int a = 0; a < 16; ++a) {
            const int j = 2 * a + hf; const bool forced = (j == 0) || (j == cur) || (j == cur - 1);
            own[a] = j <= cur ? impL[a * 64 + lane] + (forced ? 1000.f : 0.f) : -1e30f;
        }
#pragma unroll
        for (int a = 0; a < 16; ++a) { oth[a] = __shfl_xor(own[a], 32); impL[a * 64 + lane] = own[a]; }
        unsigned bits = 0u;
#pragma unroll 1
        for (int a = 0; a < 16; ++a) {
            int rank = 0; const float y = impL[a * 64 + lane]; const int ao = hf ? a + 1 : a;
#pragma unroll
            for (int c = 0; c < 16; ++c) {
                rank += (own[c] > y || (own[c] == y && c < a)) ? 1 : 0;
                rank += (oth[c] > y || (oth[c] == y && c < ao)) ? 1 : 0;
            }
            const int j = 2 * a + hf;
            if (j <= cur && rank < 16) bits |= 1u << j;
        }
        const unsigned msk = bits | (unsigned)__shfl_xor((int)bits, 32);
        if (hf == 0) ((unsigned*)(p.ws + WS_MSK))[(size_t)(b * 2 + g) * T + tq] = msk;
    }
}

__device__ __forceinline__ void osm3_tile(f32x16& s, float& l, f32x16 (&o)[2], const bf16x8 (&vf)[4]) {
    float ps = 0.f;
#pragma unroll
    for (int r = 0; r < 16; ++r) { s[r] = ex2(s[r]); ps += s[r]; }
    l += ps;
#pragma unroll
    for (int kc = 0; kc < 2; ++kc) {
        const bf16x8 pb = pack8(s[8 * kc + 0], s[8 * kc + 1], s[8 * kc + 2], s[8 * kc + 3], s[8 * kc + 4], s[8 * kc + 5], s[8 * kc + 6], s[8 * kc + 7]);
#pragma unroll
        for (int dt = 0; dt < 2; ++dt) o[dt] = mfma32(vf[kc * 2 + dt], pb, o[dt]);
    }
}
__device__ __forceinline__ void slc_next(unsigned& U, int& j, int& sub, const int q0, const bool first) {
    if (!first) { if (j >= 32) return; if (sub == 0 && j * 64 + 32 <= q0 + 31) { sub = 1; return; } }
    sub = 0; if (U) { j = __builtin_ctz(U); U &= U - 1; } else j = 32;
}
__device__ __forceinline__ void ws_unit(const Params& p, const int b, const int hq, const int qt, const LAS float* tbl) {
    const int lane = otid() & 63, ql = lane & 31, hf = lane >> 5;
    const int g = hq >> 2, q0 = qt * 32, tq = q0 + ql; const size_t rowq = (size_t)b * T + tq;
    const bf16_t* proj = (const bf16_t*)(p.ws + WS_PROJ); float* mix = (float*)(p.ws + WS_MIX);
    const bf16_t* KSb = (const bf16_t*)(p.ws + WS_KS) + (size_t)(b * 2 + g) * 64 * 2048;
    const bf16_t* KWb = (const bf16_t*)(p.ws + WS_KW) + (size_t)(b * 2 + g) * 64 * 2048;
    const bf16_t* VSb = (const bf16_t*)(p.ws + WS_VST) + (size_t)(b * 2 + g) * 128 * 64 * 16;
    const bf16_t* VWb = (const bf16_t*)(p.ws + WS_VWT) + (size_t)(b * 2 + g) * 128 * 64 * 16;
    const LAS float* tS = tbl + hq * TBL_H; const LAS float* tW = tS + TS_N;
    const unsigned msk = ((const unsigned*)(p.ws + WS_MSK))[(size_t)(b * 2 + g) * T + tq];
    bf16x8 qf[4];
#pragma unroll
    for (int kk = 0; kk < 4; ++kk) qf[kk] = *(const bf16x8*)((const bf16_t*)(p.ws + WS_QN) + rowq * 512 + hq * 64 + kk * 16 + hf * 8);
    const float graw_s = bf2f(proj[rowq * NPJ + C_AG + hq * 3 + 1]), graw_w = bf2f(proj[rowq * NPJ + C_AG + hq * 3 + 2]);
    f32x16 o[2]; float l = 0.f;
#pragma unroll
    for (int dt = 0; dt < 2; ++dt)
#pragma unroll
        for (int r = 0; r < 16; ++r) o[dt][r] = 0.f;
    bf16x8 kA[4], kB[4], vA[4], vB[4];
    {
        const int ktlo = (q0 > 511 ? q0 - 511 : 0) >> 5;
        LOADK4F(kA, KWb + (size_t)ktlo * 2048); LOADV4(vA, VWb + (size_t)(ktlo * 2) * 1024);
        { const int t1 = ktlo < qt ? ktlo + 1 : qt; LOADK4F(kB, KWb + (size_t)t1 * 2048); LOADV4(vB, VWb + (size_t)(t1 * 2) * 1024); }
        PIN4(kA); PIN4(vA); PIN4(kB); PIN4(vB);
        for (int kt = ktlo; kt <= qt; kt += 2) {
            const int ka = kt + 2 < qt ? kt + 2 : qt, kb = kt + 3 < qt ? kt + 3 : qt;
            {
                f32x16 s;
#pragma unroll
                for (int r = 0; r < 16; ++r) s[r] = 0.f;
#pragma unroll
                for (int kk = 0; kk < 4; ++kk) s = mfma32(kA[kk], qf[kk], s);
                LOADK4F(kA, KWb + (size_t)ka * 2048);
                const LAS float* tb = tW + (tq - kt * 32 + 5 - 4 * hf);
#pragma unroll
                for (int r = 0; r < 16; ++r) s[r] += tb[27 - (r & 3) - 8 * (r >> 2)];
                osm3_tile(s, l, o, vA);
                LOADV4(vA, VWb + (size_t)(ka * 2) * 1024);
            }
            {
                const bool real = kt + 1 <= qt;
                f32x16 s;
#pragma unroll
                for (int r = 0; r < 16; ++r) s[r] = 0.f;
#pragma unroll
                for (int kk = 0; kk < 4; ++kk) s = mfma32(kB[kk], qf[kk], s);
                LOADK4F(kB, KWb + (size_t)kb * 2048);
                const LAS float* tb = real ? tW + (tq - (kt + 1) * 32 + 5 - 4 * hf) : tS;
#pragma unroll
                for (int r = 0; r < 16; ++r) s[r] += tb[27 - (r & 3) - 8 * (r >> 2)];
                osm3_tile(s, l, o, vB);
                LOADV4(vB, VWb + (size_t)(kb * 2) * 1024);
            }
        }
        const float lt = l + __shfl_xor(l, 32); const float sc = (lt > 0.f ? 1.f / lt : 0.f) * sigmoidf_(graw_w);
        f32x4 c[2][4];
#pragma unroll
        for (int dt = 0; dt < 2; ++dt)
#pragma unroll
            for (int rg = 0; rg < 4; ++rg) c[dt][rg] = *(const f32x4*)(mix + rowq * DM + hq * 64 + dt * 32 + 8 * rg + 4 * hf);
#pragma unroll
        for (int dt = 0; dt < 2; ++dt)
#pragma unroll
            for (int rg = 0; rg < 4; ++rg)
                *(f32x4*)(mix + rowq * DM + hq * 64 + dt * 32 + 8 * rg + 4 * hf) = (f32x4){c[dt][rg][0] + o[dt][4 * rg] * sc, c[dt][rg][1] + o[dt][4 * rg + 1] * sc, c[dt][rg][2] + o[dt][4 * rg + 2] * sc, c[dt][rg][3] + o[dt][4 * rg + 3] * sc};
    }
    {
        l = 0.f;
#pragma unroll
        for (int dt = 0; dt < 2; ++dt)
#pragma unroll
            for (int r = 0; r < 16; ++r) o[dt][r] = 0.f;
        unsigned U = msk;
#pragma unroll
        for (int off = 1; off < 32; off <<= 1) U |= (unsigned)__shfl_xor((int)U, off);
        U = (unsigned)__builtin_amdgcn_readfirstlane((int)U);
        int j0 = 32, s0 = 0; slc_next(U, j0, s0, q0, true);
        int j1 = j0, s1 = s0; slc_next(U, j1, s1, q0, false);
        int j2 = j1, s2 = s1; slc_next(U, j2, s2, q0, false);
        int j3 = j2, s3 = s2; slc_next(U, j3, s3, q0, false);
        if (j0 < 32) {
            const int ka = j0 * 64 + s0 * 32, kb = j1 < 32 ? j1 * 64 + s1 * 32 : ka;
            LOADK4F(kA, KSb + (size_t)(ka >> 5) * 2048); LOADV4(vA, VSb + (size_t)(ka >> 4) * 1024); LOADK4F(kB, KSb + (size_t)(kb >> 5) * 2048); LOADV4(vB, VSb + (size_t)(kb >> 4) * 1024);
            PIN4(kA); PIN4(vA); PIN4(kB); PIN4(vB);
        }
        while (j0 < 32) {
            const int k0 = j0 * 64 + s0 * 32, k1 = j1 * 64 + s1 * 32;
            const int k2 = j2 < 32 ? j2 * 64 + s2 * 32 : k0, k3 = j3 < 32 ? j3 * 64 + s3 * 32 : k0;
            {
                const float madd = ((msk >> j0) & 1u) ? 0.f : -1e30f;
                f32x16 s;
#pragma unroll
                for (int r = 0; r < 16; ++r) s[r] = madd;
#pragma unroll
                for (int kk = 0; kk < 4; ++kk) s = mfma32(kA[kk], qf[kk], s);
                LOADK4F(kA, KSb + (size_t)(k2 >> 5) * 2048);
                const LAS float* tb = tS + (tq - k0 + 5 - 4 * hf);
#pragma unroll
                for (int r = 0; r < 16; ++r) s[r] += tb[27 - (r & 3) - 8 * (r >> 2)];
                osm3_tile(s, l, o, vA);
                LOADV4(vA, VSb + (size_t)(k2 >> 4) * 1024);
            }
            {
                const bool real = j1 < 32;
                const float madd = (real && ((msk >> (j1 & 31)) & 1u)) ? 0.f : -1e30f;
                f32x16 s;
#pragma unroll
                for (int r = 0; r < 16; ++r) s[r] = madd;
#pragma unroll
                for (int kk = 0; kk < 4; ++kk) s = mfma32(kB[kk], qf[kk], s);
                LOADK4F(kB, KSb + (size_t)(k3 >> 5) * 2048);
                const LAS float* tb = real ? tS + (tq - k1 + 5 - 4 * hf) : tS;
#pragma unroll
                for (int r = 0; r < 16; ++r) s[r] += tb[27 - (r & 3) - 8 * (r >> 2)];
                osm3_tile(s, l, o, vB);
                LOADV4(vB, VSb + (size_t)(k3 >> 4) * 1024);
            }
            j0 = j2; s0 = s2; j1 = j3; s1 = s3;
            j2 = j3; s2 = s3; slc_next(U, j2, s2, q0, false);
            j3 = j2; s3 = s2; slc_next(U, j3, s3, q0, false);
        }
        const float lt = l + __shfl_xor(l, 32); const float sc = (lt > 0.f ? 1.f / lt : 0.f) * sigmoidf_(graw_s);
        f32x4 c[2][4];
#pragma unroll
        for (int dt = 0; dt < 2; ++dt)
#pragma unroll
            for (int rg = 0; rg < 4; ++rg) c[dt][rg] = *(const f32x4*)(mix + rowq * DM + hq * 64 + dt * 32 + 8 * rg + 4 * hf);
#pragma unroll
        for (int dt = 0; dt < 2; ++dt)
#pragma unroll
            for (int rg = 0; rg < 4; ++rg)
                *(f32x4*)(mix + rowq * DM + hq * 64 + dt * 32 + 8 * rg + 4 * hf) = (f32x4){c[dt][rg][0] + o[dt][4 * rg] * sc, c[dt][rg][1] + o[dt][4 * rg + 1] * sc, c[dt][rg][2] + o[dt][4 * rg + 2] * sc, c[dt][rg][3] + o[dt][4 * rg + 3] * sc};
    }
}

__device__ __forceinline__ void sb_unit(const Params& p, const int b, const int h, const int qt) {
    const int lane = otid() & 63, ql = lane & 31, hf = lane >> 5;
    const int q0 = qt * 32, tq = q0 + ql; const size_t rowq = (size_t)b * T + tq;
    float* mix = (float*)(p.ws + WS_MIX);
    const bf16_t* DQ = (const bf16_t*)(p.ws + WS_DQ);
    const bf16_t* DKb = (const bf16_t*)(p.ws + WS_DK) + (size_t)(b * 8 + h) * 64 * 2048;
    const bf16_t* DVb = (const bf16_t*)(p.ws + WS_DVT) + (size_t)(b * 8 + h) * 128 * 64 * 16;
    bf16x8 qf[4];
#pragma unroll
    for (int kk = 0; kk < 4; ++kk) qf[kk] = *(const bf16x8*)(DQ + rowq * 512 + h * 64 + kk * 16 + hf * 8);
    f32x16 o[2];
#pragma unroll
    for (int dt = 0; dt < 2; ++dt)
#pragma unroll
        for (int r = 0; r < 16; ++r) o[dt][r] = 0.f;
    float carry = 0.f;
    bf16x8 kA[4], kB[4], vA[4];
    LOADK4F(kA, DKb + (size_t)qt * 2048);
    PIN4(kA);
    for (int kt = qt; kt >= 0; --kt) {
        const int k0 = kt * 32, kp = kt > 0 ? kt - 1 : 0;
        LOADK4F(kB, DKb + (size_t)kp * 2048); LOADV4(vA, DVb + (size_t)(kt * 2) * 1024);
        f32x16 s;
#pragma unroll
        for (int r = 0; r < 16; ++r) s[r] = 0.f;
#pragma unroll
        for (int kk = 0; kk < 4; ++kk) s = mfma32(kA[kk], qf[kk], s);
        float lm[16];
#pragma unroll
        for (int r = 0; r < 16; ++r) {
            const int key = k0 + (r & 3) + 8 * (r >> 2) + 4 * hf; const bool valid = key < tq; const float z = s[r];
            const float sp = fmaxf(z, 0.f) + __logf(1.f + __expf(-fabsf(z)));
            lm[r] = valid ? -sp : 0.f; s[r] = valid ? z - sp : -1e30f;
        }
        float G[4], Go[4];
#pragma unroll
        for (int rg = 0; rg < 4; ++rg) { G[rg] = (lm[4 * rg] + lm[4 * rg + 1]) + (lm[4 * rg + 2] + lm[4 * rg + 3]); Go[rg] = __shfl_xor(G[rg], 32); }
        float after = carry;
#pragma unroll
        for (int rg = 3; rg >= 0; --rg) {
            float tail = after + (hf ? 0.f : Go[rg]);
#pragma unroll
            for (int j = 3; j >= 0; --j) { const int r = 4 * rg + j; const float a = s[r] > -1e29f ? __expf(s[r] + tail) : 0.f; tail += lm[r]; s[r] = a; }
            after += G[rg] + Go[rg];
        }
        carry = after;
#pragma unroll
        for (int kc = 0; kc < 2; ++kc) {
            const bf16x8 pb = pack8(s[8 * kc + 0], s[8 * kc + 1], s[8 * kc + 2], s[8 * kc + 3], s[8 * kc + 4], s[8 * kc + 5], s[8 * kc + 6], s[8 * kc + 7]);
#pragma unroll
            for (int dt = 0; dt < 2; ++dt) o[dt] = mfma32(vA[kc * 2 + dt], pb, o[dt]);
        }
        COPY4(kA, kB);
        if (__all(carry < -105.f ? 1 : 0)) break;
    }
#pragma unroll
    for (int dt = 0; dt < 2; ++dt)
#pragma unroll
        for (int rg = 0; rg < 4; ++rg)
            *(f32x4*)(mix + rowq * DM + 1536 + h * 64 + dt * 32 + 8 * rg + 4 * hf) = (f32x4){o[dt][4 * rg], o[dt][4 * rg + 1], o[dt][4 * rg + 2], o[dt][4 * rg + 3]};
}

__device__ __forceinline__ int rel_bucket_dev(const int n) {
    if (n < 16) return n;
    const float nf = (float)n;
    int large = 16 + (int)(logf(nf / 16.f) / 4.1588830833596715f * 16.f);
    return large < 31 ? large : 31;
}
#define XB_TMO      128
#define XB_XCNT(j)  (256  + 64 * (j))
#define XB_XSUB(j)  (1280 + 64 * (j))
#define XB_XGEN(j)  (2304 + 64 * (j))
#define XB_TOP      3328
#define XB_TOPGEN   3392
#define XCD_BAR_WORDS 3456
#define XB_SPIN_CAP (1u << 18)

__device__ __forceinline__ unsigned xb_ld(unsigned* p)              { return __hip_atomic_load(p, __ATOMIC_RELAXED, __HIP_MEMORY_SCOPE_AGENT); }
__device__ __forceinline__ unsigned xb_add(unsigned* p, unsigned v) { return __hip_atomic_fetch_add(p, v, __ATOMIC_RELAXED, __HIP_MEMORY_SCOPE_AGENT); }
__device__ __forceinline__ unsigned xb_xcc_id() { return (unsigned)__builtin_amdgcn_s_getreg((3 << 11) | 20) & 0xFu; }
#define XB_SPIN(cond, bar) do { unsigned _sp = 0; while (cond) { __builtin_amdgcn_s_sleep(1); \
    if ((++_sp & 255u) == 0u) { if (xb_ld(&(bar)[XB_TMO])) break; if (_sp > XB_SPIN_CAP) { atomicAdd(&(bar)[XB_TMO], 1u); break; } } } } while (0)

struct XcdBarrier {
    unsigned* bar; unsigned x;
    volatile LAS unsigned* st;
};

__device__ __forceinline__ XcdBarrier xcd_barrier_post(unsigned* bar, volatile LAS unsigned* st) {
    XcdBarrier b; b.bar = bar; b.x = xb_xcc_id(); b.st = st;
    if (threadIdx.x == 0) (void)xb_add(&bar[XB_XCNT(b.x)], 1u);
    return b;
}
__device__ __forceinline__ void xcd_barrier_complete(unsigned* bar, unsigned x, unsigned& nloc, unsigned& nx) {
    const unsigned G = gridDim.x * gridDim.y * gridDim.z;
    unsigned sum, cnt, mine, sp = 0u;
    for (;;) {
        sum = 0u; cnt = 0u; mine = 0u;
#pragma unroll
        for (unsigned j = 0; j < 16; ++j) { const unsigned c = xb_ld(&bar[XB_XCNT(j)]); sum += c; cnt += (c > 0u) ? 1u : 0u; mine = (j == x) ? c : mine; }
        if (sum == G) break;
        __builtin_amdgcn_s_sleep(1);
        if ((++sp & 255u) == 0u) { if (xb_ld(&bar[XB_TMO])) break; if (sp > XB_SPIN_CAP) { atomicAdd(&bar[XB_TMO], 1u); break; } }
    }
    nloc = mine > 0u ? mine : 1u; nx = cnt > 0u ? cnt : 1u;
}

__device__ __forceinline__ void xcd_barrier(const XcdBarrier& b) {
    asm volatile("s_waitcnt vmcnt(0)" ::: "memory");
    __syncthreads();
    if (threadIdx.x == 0) {
        unsigned* bar = b.bar;
        __builtin_amdgcn_s_waitcnt(0);
        unsigned nloc = b.st[0], nx = b.st[1];
        if (nloc == 0u) { xcd_barrier_complete(bar, b.x, nloc, nx); b.st[0] = nloc; b.st[1] = nx; }
        const unsigned old = xb_add(&bar[XB_XSUB(b.x)], 1u);
        const unsigned gen = old / nloc;
        if (old + 1u == (gen + 1u) * nloc) {
            __builtin_amdgcn_fence(__ATOMIC_RELEASE, "agent");
            asm volatile("s_waitcnt vmcnt(0)" ::: "memory");
            const unsigned og = xb_add(&bar[XB_TOP], 1u);
            const unsigned tg = og / nx;
            if (og + 1u == (tg + 1u) * nx) xb_add(&bar[XB_TOPGEN], 1u);
            else XB_SPIN(xb_ld(&bar[XB_TOPGEN]) == tg, bar);
            __builtin_amdgcn_fence(__ATOMIC_ACQUIRE, "agent");
            xb_add(&bar[XB_XGEN(b.x)], 1u);
            asm volatile("s_waitcnt vmcnt(0)" ::: "memory");
        } else {
            XB_SPIN(xb_ld(&bar[XB_XGEN(b.x)]) == gen, bar);
            __builtin_amdgcn_fence(__ATOMIC_ACQUIRE, "agent");
            asm volatile("s_waitcnt vmcnt(0)" ::: "memory");
        }
    }
    __syncthreads();
}

__device__ __forceinline__ void finalize_rows(const Params& p, const int layer) {
    const int lane = otid() & 63, wave = otid() >> 6;
    const float* mix = (const float*)(p.ws + WS_MIX); bf16_t* out = (bf16_t*)(p.ws + WS_ABUF); const float* gg = p.in[I_GG] + (size_t)layer * DM;
    f32x4 gav[4], gcv[4];
#pragma unroll
    for (int g = 0; g < 4; ++g) { gav[g] = *(const f32x4*)(gg + g * 512 + lane * 8); gcv[g] = *(const f32x4*)(gg + g * 512 + lane * 8 + 4); }
    for (int row = blockIdx.x * 8 + wave; row < MROWS; row += gridDim.x * 8) {
        f32x4 a[4], c[4];
#pragma unroll
        for (int g = 0; g < 4; ++g) { const float* src = mix + (size_t)row * DM + g * 512 + lane * 8; a[g] = *(const f32x4*)(src); c[g] = *(const f32x4*)(src + 4); }
#pragma unroll
        for (int g = 0; g < 4; ++g) {
            float ss = a[g][0] * a[g][0] + a[g][1] * a[g][1] + a[g][2] * a[g][2] + a[g][3] * a[g][3] + c[g][0] * c[g][0] + c[g][1] * c[g][1] + c[g][2] * c[g][2] + c[g][3] * c[g][3];
            ss = wave_sum(ss); const float r = rsqrtf(ss * (1.f / 512.f) + 1e-6f);
            const f32x4 ga = gav[g], gc = gcv[g];
            *(bf16x8*)(out + (size_t)row * DM + g * 512 + lane * 8) = pack8(a[g][0] * r * ga[0], a[g][1] * r * ga[1], a[g][2] * r * ga[2], a[g][3] * r * ga[3], c[g][0] * r * gc[0], c[g][1] * r * gc[1], c[g][2] * r * gc[2], c[g][3] * r * gc[3]);
        }
    }
}

__device__ __forceinline__ int q_grab(unsigned* ctr) {
    int v = 0; if ((otid() & 63) == 0) v = (int)__hip_atomic_fetch_add(ctr, 1u, __ATOMIC_RELAXED, __HIP_MEMORY_SCOPE_AGENT);
    return __builtin_amdgcn_readfirstlane(v);
}
#ifdef PROBE_SEQ
constexpr int PH_PER_LAYER = 10, N_PHASES = 4 * (sizeof((int[])PROBE_SEQ) / sizeof(int));
#else
constexpr int PH_PER_LAYER = 10, N_PHASES = 4 * PH_PER_LAYER;
#endif

__global__ void __launch_bounds__(512, 2) mk_fwd(Params p0) {
    extern __shared__ __attribute__((aligned(16))) unsigned char lds_raw[];
    LAS unsigned char* lds = (LAS unsigned char*)lds_raw;
    cg::grid_group grid = cg::this_grid();
    const int G = gridDim.x, blk = blockIdx.x;
    volatile LAS unsigned* xst = (volatile LAS unsigned*)(lds + LDS_BYTES - 16);
    { const int t0 = otid(); if (t0 < 4) xst[t0] = 0u; }
    __syncthreads();
    XcdBarrier xbar = xcd_barrier_post((unsigned*)(p0.ws + WS_BAR), xst);
    for (int ph = p0.ph_lo; ph < p0.ph_hi; ++ph) {
        if (ph == p0.ph_lo + 1) grid.sync();
        else if (ph > p0.ph_lo) xcd_barrier(xbar);
        Params p = p0;
        {
            typedef __attribute__((address_space(1))) unsigned char* gp_t;
            gp_t gws = (gp_t)p0.ws, gout = (gp_t)p0.out;
            asm volatile("" : "+s"(gws), "+s"(gout));
            p.ws = (unsigned char*)gws; p.out = (float*)gout;
        }
#define LAUNDER_IN(i) do { typedef __attribute__((address_space(1))) unsigned char* gp2_t; gp2_t gi_ = (gp2_t)p0.in[i]; asm volatile("" : "+s"(gi_)); p.in[i] = (const float*)gi_; } while (0)
        bf16_t* abuf = (bf16_t*)(p.ws + WS_ABUF);
#ifdef PROBE_SEQ
        constexpr int kSeq[] = PROBE_SEQ; constexpr int kSeqN = sizeof(kSeq) / sizeof(int);
        const int layer = ph / kSeqN; int sp = 0;
#pragma unroll
        for (int i = 0; i < kSeqN; ++i) if (ph % kSeqN == i) sp = kSeq[i];
#else
        const int layer = ph / PH_PER_LAYER, sp = ph % PH_PER_LAYER;
#endif
#ifdef REPEAT_SP
        for (int rep = 0; rep < ((sp == REPEAT_SP) ? 2 : 1); ++rep) {
        __syncthreads();
#endif
        if (sp == 0) {
            LAUNDER_IN(I_X); LAUNDER_IN(I_NMIX); LAUNDER_IN(I_WIN); LAUNDER_IN(I_WOUT); LAUNDER_IN(I_WG); LAUNDER_IN(I_WU); LAUNDER_IN(I_WD);
#ifndef SKIP_P0
            phase_weights(p, layer, lds);
            rmsnorm_rows(layer == 0 ? p.in[I_X] : p.out, p.in[I_NMIX] + (size_t)layer * DM, abuf);
#endif
        } else if (sp == 1) {
            pg8::Gemm g{abuf, (const bf16_t*)(p.ws + WS_WIN), MROWS, NPJ, DM}; pg8::StaticOrder S; S.init(MROWS, NPJ, G, blk);
            EpiF32 E{(bf16_t*)(p.ws + WS_PROJ), NPJ};
#ifndef SKIP_G1
            pg8::gemm_phase<EpiF32, pg8::StaticOrder, true, true>(lds, g, S, E);
            LAUNDER_IN(I_WOUT); LAUNDER_IN(I_WG); LAUNDER_IN(I_WU); LAUNDER_IN(I_WD);
            weights_queue(p, layer, lds, (unsigned*)(p.ws + WS_BAR + 16384 + 4096) + layer * 16);
#endif
        } else if (sp == 2) {
            LAUNDER_IN(I_QG); LAUNDER_IN(I_KG); LAUNDER_IN(I_CONV); LAUNDER_IN(I_SGW); LAUNDER_IN(I_SGB); LAUNDER_IN(I_CPOS); LAUNDER_IN(I_CW1); LAUNDER_IN(I_CW2); LAUNDER_IN(I_REL);
            for (int u = blk; u < 256; u += G) token_prep_unit(p, layer, u);
            for (int u = blk; u < 256; u += G) sgu_unit(p, layer, u, lds);
            for (int u = blk; u < 256; u += G) compress_unit(p, layer, u, lds);
            {
                const int tid = otid();
                if (blk == 0 && tid < 64) {
                    float gq = fabsf(p.in[I_QG][layer * 64 + tid]), gk = fabsf(p.in[I_KG][layer * 64 + tid]);
                    const float r0 = p.in[I_REL][tid], r1 = p.in[I_REL][tid + 64], r2 = p.in[I_REL][tid + 128], r3 = p.in[I_REL][tid + 192];
                    float bm = fmaxf(fmaxf(fabsf(r0), fabsf(r1)), fmaxf(fabsf(r2), fabsf(r3)));
#pragma unroll
                    for (int o = 1; o < 64; o <<= 1) { gq = fmaxf(gq, __shfl_xor(gq, o)); gk = fmaxf(gk, __shfl_xor(gk, o)); }
#pragma unroll
                    for (int o = 8; o < 64; o <<= 1) bm = fmaxf(bm, __shfl_xor(bm, o));
                    if (tid < 8) ((float*)(p.ws + WS_BAR + 16384 + 16384 - 64))[tid] = fminf(64.f * 0.125f * LOG2E * gq * gk + bm * LOG2E, 60.f);
                }
            }
        } else if (sp == 3) {
            LAUNDER_IN(I_REL);
            const int tid = otid(), wave = __builtin_amdgcn_readfirstlane(tid >> 6);
            LAS float* tbl = (LAS float*)lds; const float* m0g = (const float*)(p.ws + WS_BAR + 16384 + 16384 - 64);
            for (int idx = tid; idx < TBL_ALL; idx += 512) {
                const int h = idx / TBL_H, i = idx - h * TBL_H; const bool isS = i < TS_N; const int dist = (isS ? i : i - TS_N) - 32;
                const bool ok = dist >= 0 && (isS || dist < 512);
                tbl[idx] = ok ? p.in[I_REL][rel_bucket_dev(dist) * 8 + h] * LOG2E - m0g[h] : -1e30f;
            }
            __syncthreads();
            const int gw = wave * G + blk, NW = 8 * G;
            if (NW >= 2048 && (G & 7) == 0) {
                if (gw < 1024) {
#ifndef SKIP_NSA
                    cmp_unit(p, gw, tbl, tbl + TBL_ALL + wave * 1024, tbl + TBL_ALL + 8192 + wave * 1024);
#endif
                }
                unsigned* ctr = (unsigned*)(p.ws + WS_BAR + 16384) + (layer * 8 + (blk & 7)) * 16;
                int u = q_grab(ctr);
                while (u < 512) {
                    const int un = q_grab(ctr);
#ifndef SKIP_SB
                    sb_unit(p, blk & 7, u & 7, 63 - (u >> 3));
#endif
                    u = un;
                }
            } else {
                for (int un = gw; un < 1024; un += NW) cmp_unit(p, un, tbl, tbl + TBL_ALL + wave * 1024, tbl + TBL_ALL + 8192 + wave * 1024);
                for (int ud = gw; ud < 4096; ud += NW) { const int bh = ud & 63; sb_unit(p, bh & 7, bh >> 3, 63 - (ud >> 6)); }
            }
        } else if (sp == 4) {
            const int tid = otid(), wave = __builtin_amdgcn_readfirstlane(tid >> 6);
            const LAS float* tbl = (const LAS float*)lds;
            if ((G & 7) == 0) {
                unsigned* ctr = (unsigned*)(p.ws + WS_BAR + 16384 + 8192) + (layer * 8 + (blk & 7)) * 16;
                volatile LAS int* slot = (volatile LAS int*)(lds + LDS_BYTES - 64);
                for (;;) {
                    if (otid() == 0) slot[0] = (int)__hip_atomic_fetch_add(ctr, 1u, __ATOMIC_RELAXED, __HIP_MEMORY_SCOPE_AGENT);
                    __syncthreads();
                    const int u = slot[0];
                    if (u >= 64) break;
#ifndef SKIP_WS
                    ws_unit(p, blk & 7, (u & 1) * 4 + (wave & 3), 63 - 2 * (u >> 1) - (wave >> 2), tbl);
#endif
                    __syncthreads();
                }
            } else {
                const int gw = wave * G + blk, NW = 8 * G;
                for (int uu = gw; uu < 2048; uu += NW) {
                    const int bh = uu & 63, qa = uu >> 6;
                    ws_unit(p, bh & 7, bh >> 3, 63 - qa, tbl);
                    ws_unit(p, bh & 7, bh >> 3, qa, tbl);
                }
            }
        } else if (sp == 5) {
            LAUNDER_IN(I_GG);
#ifndef SKIP_FIN
            finalize_rows(p, layer);
#endif
        } else if (sp == 6) {
            LAUNDER_IN(I_X);
            pg8::Gemm g{abuf, (const bf16_t*)(p.ws + WS_WOUT), MROWS, DM, DM}; pg8::StaticOrder S; S.init(MROWS, DM, G, blk);
            EpiResid E{layer == 0 ? p.in[I_X] : p.out, p.out, DM};
#ifndef SKIP_G2
            pg8::gemm_phase<EpiResid, pg8::StaticOrder, true, true>(lds, g, S, E);
#endif
        } else if (sp == 7) {
            LAUNDER_IN(I_NFFN);
#ifndef SKIP_RN
            rmsnorm_rows(p.out, p.in[I_NFFN] + (size_t)layer * DM, abuf);
#endif
        } else if (sp == 8) {
            pg8::Gemm g{abuf, (const bf16_t*)(p.ws + WS_WGU), MROWS, NGU, DM}; pg8::StaticOrder S; S.init(MROWS, NGU, G, blk);
            EpiSwiglu E{(bf16_t*)(p.ws + WS_PROJ), DFF};
#ifndef SKIP_G3
            pg8::gemm_phase<EpiSwiglu, pg8::StaticOrder, true, true>(lds, g, S, E);
#endif
        } else {
            pg8::Gemm g{(const bf16_t*)(p.ws + WS_PROJ), (const bf16_t*)(p.ws + WS_WDN), MROWS, DM, DFF}; pg8::StaticOrder S; S.init(MROWS, DM, G, blk);
            EpiResid E{p.out, p.out, DM};
#ifndef SKIP_G2
            pg8::gemm_phase<EpiResid, pg8::StaticOrder, true, true>(lds, g, S, E);
#endif
        }
#ifdef REPEAT_SP
        }
#endif
    }
}

extern "C" void kernel_launch(void* const* d_in, const int* in_sizes, int n_in, void* d_out, int out_size, void* d_ws, size_t ws_size, hipStream_t stream) {
    static int grid_blocks = 0;
    if (!grid_blocks) {
        hipFuncSetAttribute((const void*)mk_fwd, hipFuncAttributeMaxDynamicSharedMemorySize, LDS_BYTES);
        int dev = 0, cus = 0, per_cu = 0;
        hipGetDevice(&dev);
        hipDeviceGetAttribute(&cus, hipDeviceAttributeMultiprocessorCount, dev);
        hipOccupancyMaxActiveBlocksPerMultiprocessor(&per_cu, mk_fwd, 512, LDS_BYTES);
        if (per_cu < 1) fprintf(stderr, "occupancy query returned %d\n", per_cu);
        grid_blocks = cus;
    }
    if (ws_size < WS_END) { fprintf(stderr, "workspace too small: %zu < %zu\n", ws_size, (size_t)WS_END); return; }
    Params p{};
    for (int i = 0; i < 18; ++i) p.in[i] = (const float*)d_in[i];
    p.out = (float*)d_out; p.ws = (unsigned char*)d_ws; p.ph_lo = 0; p.ph_hi = N_PHASES;
    void* args[] = {&p};
    (void)hipMemsetAsync((unsigned char*)d_ws + WS_BAR, 0, 32768, stream);
    hipError_t e = hipLaunchCooperativeKernel((void*)mk_fwd, dim3(grid_blocks), dim3(512), args, LDS_BYTES, stream);
    if (e != hipSuccess) fprintf(stderr, "cooperative launch failed: %s (grid %d)\n", hipGetErrorString(e), grid_blocks);
}
```

```cpp
#include <hip/hip_runtime.h>
#include <hip/hip_cooperative_groups.h>
#include <cstdio>
#include <cstdint>
namespace cg = cooperative_groups;
__device__ __forceinline__ int otid() { int t = threadIdx.x; asm volatile("" : "+v"(t)); return t; }
namespace pg8 {
#define PG8_LAS __attribute__((address_space(3)))
typedef unsigned short bf16_t;
typedef short bf16x8 __attribute__((ext_vector_type(8)));
typedef float f32x4 __attribute__((ext_vector_type(4)));
typedef unsigned u32x4 __attribute__((ext_vector_type(4)));
constexpr int BM = 256, BK = 64, HALF = 128, HTB = HALF * BK * 2  , STAGE_BYTES = 8 * HTB, NXCD = 8, WGM = 8;

__host__ __device__ __forceinline__ int lds_byte(int r, int c) { const int st = (r >> 4) * 2 + (c >> 5), rr = r & 15, cc = c & 31, ob = rr * 64 + cc * 2; return st * 1024 + (ob ^ (((ob >> 9) & 1) << 5)); }
__host__ __device__ __forceinline__ void stage_rc(int b, int& R, int& C) { const int st = b / 1024, sb = b % 1024, swz = sb ^ (((sb >> 9) & 1) << 5); R = (st >> 1) * 16 + swz / 64; C = (st & 1) * 32 + (swz % 64) / 2; }
__host__ __device__ __forceinline__ int perm32(int rho) { const int n = rho >> 4, i = rho & 15; return 8 * (i >> 2) + 4 * n + (i & 3); }

struct Unit { int pm, pn; };
struct Gemm { const bf16_t* A; const bf16_t* Bt; int M, N, K; };

struct StaticOrder {
    int nM, nN, nwg, G, c;
    __host__ __device__ void init(int M, int N, int G_, int c_) { nM = M / BM; nN = N / BM; nwg = nM * nN; G = G_; c = c_; }
    __host__ __device__ bool next(int i, Unit& u) const {
        const long L = (long)i * G + c; if (L >= nwg) return false;
        int wgid = (int)L; { const int q = nwg / NXCD, r = nwg % NXCD, xcd = wgid % NXCD, off = wgid / NXCD; wgid = (xcd < r ? xcd * (q + 1) : r * (q + 1) + (xcd - r) * q) + off; }
        const int nig = WGM * nN, gid = wgid / nig, fm = gid * WGM, gsz = (nM - fm) < WGM ? (nM - fm) : WGM;
        u.pm = fm + ((wgid % nig) % gsz); u.pn = (wgid % nig) / gsz; return true;
    }
    __device__ __forceinline__ void a_ready(const Unit&) const {}
    __device__ __forceinline__ void done(const Unit&) const {}
};

__device__ __forceinline__ unsigned cvt_pk_bf16(float lo, float hi) { unsigned r; asm volatile("v_cvt_pk_bf16_f32 %0, %1, %2" : "=v"(r) : "v"(lo), "v"(hi)); return r; }
template <class Epi, class Sched, bool ALIGN_EPI = false, bool SP2 = false>
__device__ __forceinline__ void gemm_phase(PG8_LAS unsigned char* lds, const Gemm g, const Sched& S, const Epi& E) {
    const int tid = otid(), wid = __builtin_amdgcn_readfirstlane(tid >> 6), lane = tid & 63, wr = wid >> 2, wc = wid & 3, fr = lane & 15, fq = lane >> 4;
    const int K = g.K, nt = K / BK;
    unsigned voffA[2], voffB[2];
#pragma unroll
    for (int i = 0; i < 2; ++i) { int R, C; stage_rc(tid * 16 + i * 8192, R, C); const int Rb = Epi::PERM ? ((R & ~31) + perm32(R & 31)) : R;
        voffA[i] = (unsigned)(R * K + C) * 2u; voffB[i] = (unsigned)(Rb * K + C) * 2u; }
    const size_t kstep = (size_t)(BK * 2);
    const size_t hstep = (size_t)HALF * K * 2;
    const size_t tstep = 2 * hstep;
    const unsigned ldsw = (unsigned)wid * 1024u;
    const int aoff = lds_byte(wr * 64 + fr, fq * 8), boff = lds_byte(wc * 32 + fr, fq * 8);
#define PG8_SA(b, h) (((b) * 2 + (h)) * HTB)
#define PG8_SB(b, h) ((4 + (b) * 2 + (h)) * HTB)
#define PG8_STAGE(bufoff, gbase, voff) do { _Pragma("unroll") for (int _i = 0; _i < 2; ++_i) \
        __builtin_amdgcn_global_load_lds((const unsigned*)((const char*)(gbase) + (voff)[_i]), (PG8_LAS unsigned*)(lds + (bufoff) + ldsw + _i * 8192), 16, 0, 0); } while (0)
#define PG8_LDA(dst, b, h) do { _Pragma("unroll") for (int m = 0; m < 4; ++m) _Pragma("unroll") for (int k = 0; k < 2; ++k) dst[m][k] = *(const PG8_LAS bf16x8*)(lds + PG8_SA(b, h) + aoff + m * 2048 + k * 1024); } while (0)
#define PG8_LDB(dst, b, h) do { _Pragma("unroll") for (int n = 0; n < 2; ++n) _Pragma("unroll") for (int k = 0; k < 2; ++k) dst[n][k] = *(const PG8_LAS bf16x8*)(lds + PG8_SB(b, h) + boff + n * 2048 + k * 1024); } while (0)
#define PG8_MMA(ai, bj, At, Bt) do { __builtin_amdgcn_s_setprio(1); _Pragma("unroll") for (int m = 0; m < 4; ++m) _Pragma("unroll") for (int n = 0; n < 2; ++n) _Pragma("unroll") for (int k = 0; k < 2; ++k) \
        acc[ai][bj][m][n] = __builtin_amdgcn_mfma_f32_16x16x32_bf16(Bt[n][k], At[m][k], acc[ai][bj][m][n], 0, 0, 0); __builtin_amdgcn_s_setprio(0); } while (0)
#define PG8_WAIT_V(n) asm volatile("s_waitcnt vmcnt(" #n ")" ::: "memory")
#define PG8_WAIT_L(n) asm volatile("s_waitcnt lgkmcnt(" #n ")" ::: "memory")
#define PG8_BAR __builtin_amdgcn_s_barrier()
#define PG8_SCHED __builtin_amdgcn_sched_barrier(0)
    Unit cur, nxt; int ui = 0;
    if (!S.next(0, cur)) return;
    f32x4 acc[2][2][4][2];
#pragma unroll
    for (int a = 0; a < 2; ++a)
#pragma unroll
        for (int b = 0; b < 2; ++b)
#pragma unroll
            for (int m = 0; m < 4; ++m)
#pragma unroll
                for (int n = 0; n < 2; ++n) acc[a][b][m][n] = (f32x4){0.f, 0.f, 0.f, 0.f};
    bf16x8 At[4][2], B0[2][2], B1[2][2];
    const char* cA = (const char*)g.A + (size_t)cur.pm * tstep; const char* cB = (const char*)g.Bt + (size_t)cur.pn * tstep;
    S.a_ready(cur);
    if constexpr (SP2) {
        PG8_STAGE(PG8_SB(0, 0), cB, voffB); PG8_STAGE(PG8_SB(0, 1), cB + hstep, voffB); PG8_STAGE(PG8_SA(0, 0), cA, voffA); PG8_STAGE(PG8_SA(0, 1), cA + hstep, voffA);
        if (wr == 1) PG8_BAR;
        PG8_WAIT_V(2); PG8_BAR;
        PG8_STAGE(PG8_SB(1, 0), cB + kstep, voffB); PG8_STAGE(PG8_SA(1, 0), cA + kstep, voffA); PG8_STAGE(PG8_SB(1, 1), cB + hstep + kstep, voffB);
        PG8_WAIT_V(6); PG8_BAR;
    } else {
        PG8_STAGE(PG8_SB(0, 0), cB, voffB); PG8_STAGE(PG8_SA(0, 0), cA, voffA); PG8_STAGE(PG8_SB(0, 1), cB + hstep, voffB); PG8_STAGE(PG8_SA(0, 1), cA + hstep, voffA);
        if (wr == 1) PG8_BAR;
        PG8_WAIT_V(4); PG8_BAR;
        PG8_STAGE(PG8_SB(1, 0), cB + kstep, voffB); PG8_STAGE(PG8_SA(1, 0), cA + kstep, voffA); PG8_STAGE(PG8_SB(1, 1), cB + hstep + kstep, voffB);
        PG8_WAIT_V(6); PG8_BAR;
    }
    for (;;) {
        const bool has_next = S.next(ui + 1, nxt);
        const char* nA = has_next ? (const char*)g.A + (size_t)nxt.pm * tstep : cA; const char* nB = has_next ? (const char*)g.Bt + (size_t)nxt.pn * tstep : cB;
        for (int t = 0; t < nt; t += 2) {
            const bool last = (t == nt - 2);
            const char* a1 = cA + (size_t)(t + 1) * kstep;
            const char* a2 = last ? nA : cA + (size_t)(t + 2) * kstep; const char* b2 = last ? nB : cB + (size_t)(t + 2) * kstep;
            const char* a3 = a2 + kstep; const char* b3 = b2 + kstep;
            if (last && has_next) S.a_ready(nxt);
            if constexpr (SP2) {
            PG8_LDB(B0, 0, 0); PG8_LDB(B1, 0, 1); PG8_SCHED; PG8_LDA(At, 0, 0); PG8_STAGE(PG8_SA(1, 1), a1 + hstep, voffA);
            PG8_WAIT_V(8); PG8_WAIT_L(0); PG8_BAR; PG8_MMA(0, 0, At, B0); PG8_MMA(0, 1, At, B1); PG8_BAR; PG8_SCHED;
            PG8_LDA(At, 0, 1); PG8_STAGE(PG8_SB(0, 0), b2, voffB); PG8_STAGE(PG8_SB(0, 1), b2 + hstep, voffB); PG8_STAGE(PG8_SA(0, 0), a2, voffA);
            PG8_WAIT_V(8); PG8_WAIT_L(0); PG8_BAR; PG8_MMA(1, 0, At, B0); PG8_MMA(1, 1, At, B1); PG8_BAR; PG8_SCHED;
            PG8_LDB(B0, 1, 0); PG8_LDB(B1, 1, 1); PG8_SCHED; PG8_LDA(At, 1, 0); PG8_STAGE(PG8_SA(0, 1), a2 + hstep, voffA);
            PG8_WAIT_V(8); PG8_WAIT_L(0); PG8_BAR; PG8_MMA(0, 0, At, B0); PG8_MMA(0, 1, At, B1); PG8_BAR; PG8_SCHED;
            PG8_LDA(At, 1, 1); PG8_STAGE(PG8_SB(1, 0), b3, voffB); PG8_STAGE(PG8_SB(1, 1), b3 + hstep, voffB); PG8_STAGE(PG8_SA(1, 0), a3, voffA);
            PG8_WAIT_V(8); PG8_WAIT_L(0); PG8_BAR; PG8_MMA(1, 0, At, B0); PG8_MMA(1, 1, At, B1); PG8_BAR; PG8_SCHED;
            } else {
            PG8_LDB(B0, 0, 0); PG8_SCHED; PG8_LDA(At, 0, 0); PG8_STAGE(PG8_SA(1, 1), a1 + hstep, voffA);
            PG8_WAIT_L(8); PG8_BAR; PG8_WAIT_L(0); PG8_MMA(0, 0, At, B0); PG8_BAR; PG8_SCHED;
            PG8_LDB(B1, 0, 1); PG8_STAGE(PG8_SB(0, 0), b2, voffB);
            PG8_BAR; PG8_WAIT_L(0); PG8_MMA(0, 1, At, B1); PG8_BAR;
            PG8_LDA(At, 0, 1); PG8_STAGE(PG8_SA(0, 0), a2, voffA);
            PG8_BAR; PG8_WAIT_L(0); PG8_MMA(1, 0, At, B0); PG8_BAR; PG8_SCHED;
            PG8_STAGE(PG8_SB(0, 1), b2 + hstep, voffB);
            PG8_WAIT_V(6); PG8_BAR; PG8_MMA(1, 1, At, B1); PG8_BAR;
            PG8_LDB(B0, 1, 0); PG8_SCHED; PG8_LDA(At, 1, 0); PG8_STAGE(PG8_SA(0, 1), a2 + hstep, voffA);
            PG8_WAIT_L(8); PG8_BAR; PG8_WAIT_L(0); PG8_MMA(0, 0, At, B0); PG8_BAR; PG8_SCHED;
            PG8_LDB(B1, 1, 1); PG8_STAGE(PG8_SB(1, 0), b3, voffB);
            PG8_BAR; PG8_WAIT_L(0); PG8_MMA(0, 1, At, B1); PG8_BAR;
            PG8_LDA(At, 1, 1); PG8_STAGE(PG8_SA(1, 0), a3, voffA);
            PG8_BAR; PG8_WAIT_L(0); PG8_MMA(1, 0, At, B0); PG8_BAR; PG8_SCHED;
            PG8_STAGE(PG8_SB(1, 1), b3 + hstep, voffB);
            PG8_WAIT_V(6); PG8_BAR; PG8_MMA(1, 1, At, B1); PG8_BAR;
            }
        }
        if constexpr (ALIGN_EPI) { if (wr == 0) PG8_BAR; }
        if constexpr (!Epi::AFTER_DRAIN) { E(acc, cur, wr, wc, fr, fq); S.done(cur); }
        if (!has_next) break;
#pragma unroll
        for (int a = 0; a < 2; ++a)
#pragma unroll
            for (int b = 0; b < 2; ++b)
#pragma unroll
                for (int m = 0; m < 4; ++m)
#pragma unroll
                    for (int n = 0; n < 2; ++n) acc[a][b][m][n] = (f32x4){0.f, 0.f, 0.f, 0.f};
        cur = nxt; cA = nA; cB = nB; ++ui;
        if constexpr (ALIGN_EPI) { if (wr == 1) PG8_BAR; }
    }
    PG8_WAIT_V(0);
    if constexpr (!ALIGN_EPI) { if (wr == 0) PG8_BAR; }
    PG8_BAR;
    if constexpr (Epi::AFTER_DRAIN) { E.fused(acc, cur, wr, wc, fr, fq, lds, wid, lane); S.done(cur); }
#undef PG8_SA
#undef PG8_SB
#undef PG8_STAGE
#undef PG8_LDA
#undef PG8_LDB
#undef PG8_MMA
#undef PG8_WAIT_V
#undef PG8_WAIT_L
#undef PG8_BAR
#undef PG8_SCHED
}
}
using pg8::bf16_t; using pg8::bf16x8; using pg8::f32x4; using pg8::u32x4; using pg8::cvt_pk_bf16;
typedef float f32x16 __attribute__((ext_vector_type(16)));
typedef unsigned u32x2 __attribute__((ext_vector_type(2)));
#define LAS __attribute__((address_space(3)))

constexpr int T = 2048, MROWS = 16384, DM = 2048, NPJ = 5632, DFF = 5632, NGU = 11264, NIN = 5400;
constexpr int C_KC = 512, C_VC = 640, C_KS = 768, C_VS = 896, C_KW = 1024, C_VW = 1152, C_AG = 1280, C_BG = 1304, C_CG = 1816, C_BH = 2328,
              C_CU = 2840, C_CV = 3352, C_DQ = 3864, C_DK = 4376, C_DV = 4888;
constexpr int LDS_BYTES = 159744;

constexpr size_t WS_WIN = 0;
constexpr size_t WS_WOUT = WS_WIN + (size_t)NPJ * DM * 2;
constexpr size_t WS_WGU = WS_WOUT + (size_t)DM * DM * 2;
constexpr size_t WS_WDN = WS_WGU + (size_t)NGU * DM * 2;
constexpr size_t WS_ABUF = WS_WDN + (size_t)DM * DFF * 2;
constexpr size_t WS_PROJ = WS_ABUF + (size_t)MROWS * DM * 2;
constexpr size_t WS_MIX = WS_PROJ + (size_t)MROWS * NPJ * 4;
constexpr size_t WS_QN = WS_MIX + (size_t)MROWS * DM * 4;
constexpr size_t WS_KS = WS_QN + (size_t)MROWS * 512 * 2;
constexpr size_t WS_KW = WS_KS + (size_t)MROWS * 128 * 2;
constexpr size_t WS_VST = WS_KW + (size_t)MROWS * 128 * 2;
constexpr size_t WS_VWT = WS_VST + (size_t)MROWS * 128 * 2;
constexpr size_t WS_KCN = WS_VWT + (size_t)MROWS * 128 * 2;
constexpr size_t WS_VCT = WS_KCN + (size_t)16 * 128 * 64 * 2;
constexpr size_t WS_DQ = WS_VCT + (size_t)16 * 128 * 64 * 2;
constexpr size_t WS_DK = WS_DQ + (size_t)MROWS * 512 * 2;
constexpr size_t WS_DVT = WS_DK + (size_t)MROWS * 512 * 2;
constexpr size_t WS_MSK = WS_DVT + (size_t)MROWS * 512 * 2;
constexpr size_t WS_BAR = WS_MSK + (size_t)16 * 2048 * 4;
constexpr size_t WS_END = WS_BAR + 32768;

struct Params { const float* in[18]; float* out; unsigned char* ws; int ph_lo, ph_hi; };
enum { I_X = 0, I_WIN, I_WOUT, I_NMIX, I_NFFN, I_QG, I_KG, I_CPOS, I_CW1, I_CW2, I_REL, I_CONV, I_SGW, I_SGB, I_GG, I_WG, I_WU, I_WD };

__device__ __forceinline__ float wave_sum(float v) {
#pragma unroll
    for (int o = 1; o < 64; o <<= 1) v += __shfl_xor(v, o);
    return v;
}
__device__ __forceinline__ float gelu_tanh(float x) {
    const float u = 0.7978845608028654f * (x + 0.044715f * x * x * x);
    const float e = __expf(2.f * u);
    const float th = 1.f - 2.f / (e + 1.f);
    return 0.5f * x * (1.f + th);
}
__device__ __forceinline__ float sigmoidf_(float x) { return 1.f / (1.f + __expf(-x)); }
__device__ __forceinline__ bf16x8 pack8(float a0, float a1, float a2, float a3, float a4, float a5, float a6, float a7) {
    u32x4 w; w.x = cvt_pk_bf16(a0, a1); w.y = cvt_pk_bf16(a2, a3); w.z = cvt_pk_bf16(a4, a5); w.w = cvt_pk_bf16(a6, a7);
    return __builtin_bit_cast(bf16x8, w);
}
__device__ __forceinline__ float bf2f(bf16_t b) { return __uint_as_float((unsigned)b << 16); }
__device__ __forceinline__ float bflo(unsigned u) { return __uint_as_float(u << 16); }
__device__ __forceinline__ float bfhi(unsigned u) { return __uint_as_float(u & 0xffff0000u); }
struct F8 { f32x4 a, b; };
__device__ __forceinline__ F8 ld8(const bf16_t* p) {
    const u32x4 w = *(const u32x4*)p; F8 r;
    r.a = (f32x4){bflo(w.x), bfhi(w.x), bflo(w.y), bfhi(w.y)}; r.b = (f32x4){bflo(w.z), bfhi(w.z), bflo(w.w), bfhi(w.w)}; return r;
}
__device__ __forceinline__ F8 up8(const u32x4 w) { F8 r; r.a = (f32x4){bflo(w.x), bfhi(w.x), bflo(w.y), bfhi(w.y)}; r.b = (f32x4){bflo(w.z), bfhi(w.z), bflo(w.w), bfhi(w.w)}; return r; }
__device__ __forceinline__ bf16_t bf1(float a) { return (bf16_t)(cvt_pk_bf16(a, 0.f) & 0xffffu); }
__device__ __forceinline__ f32x16 mfma32(bf16x8 a, bf16x8 b, f32x16 c) { return __builtin_amdgcn_mfma_f32_32x32x16_bf16(a, b, c, 0, 0, 0); }
__device__ __forceinline__ int slot16(int ko) { return ((ko >> 2) & 1) * 8 + (ko >> 3) * 4 + (ko & 3); }

struct EpiF32 {
    static constexpr bool PERM = true, AFTER_DRAIN = false; bf16_t* O; int ldc;
    __device__ __forceinline__ void operator()(const f32x4 (&acc)[2][2][4][2], const pg8::Unit& u, int wr, int wc, int fr, int fq) const {
#pragma unroll
        for (int ai = 0; ai < 2; ++ai)
#pragma unroll
            for (int m = 0; m < 4; ++m) {
                bf16_t* rp = O + (size_t)(u.pm * 256 + ai * 128 + wr * 64 + m * 16 + fr) * ldc + u.pn * 256 + wc * 32 + fq * 8;
#pragma unroll
                for (int bj = 0; bj < 2; ++bj) {
                    const f32x4 v0 = acc[ai][bj][m][0], v1 = acc[ai][bj][m][1]; u32x4 w;
                    w.x = cvt_pk_bf16(v0[0], v0[1]); w.y = cvt_pk_bf16(v0[2], v0[3]); w.z = cvt_pk_bf16(v1[0], v1[1]); w.w = cvt_pk_bf16(v1[2], v1[3]);
                    *(u32x4*)(rp + bj * 128) = w;
                }
            }
    }
};
struct EpiResid {
    static constexpr bool PERM = true, AFTER_DRAIN = false; const float* base; float* out; int ldc;
    __device__ __forceinline__ void operator()(const f32x4 (&acc)[2][2][4][2], const pg8::Unit& u, int wr, int wc, int fr, int fq) const {
        const size_t off0 = (size_t)(u.pm * 256 + wr * 64 + fr) * ldc + u.pn * 256 + wc * 32 + fq * 8;
        f32x4 cur[2][2], nxt[2][2];
#pragma unroll
        for (int bj = 0; bj < 2; ++bj) { cur[bj][0] = *(const f32x4*)(base + off0 + bj * 128); cur[bj][1] = *(const f32x4*)(base + off0 + bj * 128 + 4); }
#pragma unroll
        for (int idx = 0; idx < 8; ++idx) {
            const int ai = idx >> 2, m = idx & 3; const size_t off = off0 + (size_t)(ai * 128 + m * 16) * ldc;
            if (idx < 7) {
                const size_t offn = off0 + (size_t)(((idx + 1) >> 2) * 128 + ((idx + 1) & 3) * 16) * ldc;
#pragma unroll
                for (int bj = 0; bj < 2; ++bj) { nxt[bj][0] = *(const f32x4*)(base + offn + bj * 128); nxt[bj][1] = *(const f32x4*)(base + offn + bj * 128 + 4); }
            }
#pragma unroll
            for (int bj = 0; bj < 2; ++bj) { *(f32x4*)(out + off + bj * 128) = cur[bj][0] + acc[ai][bj][m][0]; *(f32x4*)(out + off + bj * 128 + 4) = cur[bj][1] + acc[ai][bj][m][1]; }
#pragma unroll
            for (int bj = 0; bj < 2; ++bj) { cur[bj][0] = nxt[bj][0]; cur[bj][1] = nxt[bj][1]; }
        }
    }
};
struct EpiSwiglu {
    static constexpr bool PERM = true, AFTER_DRAIN = false; bf16_t* O; int ldc;
    __device__ __forceinline__ void operator()(const f32x4 (&acc)[2][2][4][2], const pg8::Unit& u, int wr, int wc, int fr, int fq) const {
#pragma unroll
        for (int ai = 0; ai < 2; ++ai)
#pragma unroll
            for (int m = 0; m < 4; ++m) {
                bf16_t* rp = O + (size_t)(u.pm * 256 + ai * 128 + wr * 64 + m * 16 + fr) * ldc + u.pn * 128 + wc * 32 + fq * 8;
                float r[8];
#pragma unroll
                for (int n = 0; n < 2; ++n) {
                    const f32x4 g = acc[ai][0][m][n], uu = acc[ai][1][m][n];
#pragma unroll
                    for (int j = 0; j < 4; ++j) r[4 * n + j] = g[j] * __builtin_amdgcn_rcpf(1.f + __builtin_amdgcn_exp2f(g[j] * -1.4426950408889634f)) * uu[j];
                }
                *(bf16x8*)rp = pack8(r[0], r[1], r[2], r[3], r[4], r[5], r[6], r[7]);
            }
    }
};

__device__ __forceinline__ void tt_load(const float* s0, const float* s1, const int mode, const int Nsrc, const int kt, const int nt, f32x4 (&v)[4], bool& ok) {
    const int tid = otid(); const int c4 = tid & 31, kr = tid >> 5; const int R = nt * 128 + c4 * 4; const float* s = s0; int col = R; ok = R < Nsrc;
    if (mode != 0) { s = ((R >> 7) & 1) ? s1 : s0; col = (R >> 8) * 128 + (R & 127); ok = true; }
    if (!ok) col = 0;
    const float* sp = s + (size_t)(kt * 64 + kr) * Nsrc + col;
#pragma unroll
    for (int p = 0; p < 4; ++p) v[p] = *(const f32x4*)(sp + (size_t)p * 16 * Nsrc);
}
__device__ __forceinline__ void tt_to_lds(const f32x4 (&v)[4], const bool ok, LAS float* tile) {
    const int tid = otid(); const int c4 = tid & 31, kr = tid >> 5;
#pragma unroll
    for (int p = 0; p < 4; ++p) *(LAS f32x4*)(tile + (p * 16 + kr) * 132 + c4 * 4) = ok ? v[p] : (f32x4){0.f, 0.f, 0.f, 0.f};
}
__device__ __forceinline__ void tt_store(bf16_t* dst, const int K, const int kt, const int nt, LAS float* tile) {
    const int tid = otid(); const int R = tid >> 2, kq = tid & 3; float v[16];
#pragma unroll
    for (int i = 0; i < 16; ++i) v[i] = tile[(kq * 16 + i) * 132 + R];
    bf16_t* d = dst + (size_t)(nt * 128 + R) * K + kt * 64 + kq * 16;
    *(bf16x8*)d = pack8(v[0], v[1], v[2], v[3], v[4], v[5], v[6], v[7]);
    *(bf16x8*)(d + 8) = pack8(v[8], v[9], v[10], v[11], v[12], v[13], v[14], v[15]);
}

__device__ __forceinline__ void rmsnorm_rows(const float* __restrict__ x, const float* __restrict__ g, bf16_t* __restrict__ out) {
    const int lane = otid() & 63, wave = otid() >> 6;
    f32x4 gq[8];
#pragma unroll
    for (int j = 0; j < 8; ++j) gq[j] = *(const f32x4*)(g + (j * 64 + lane) * 4);
    for (int row = (blockIdx.x * 8 + wave) * 2; row < MROWS; row += gridDim.x * 16) {
        f32x4 v[2][8]; float ss[2] = {0.f, 0.f};
#pragma unroll
        for (int q = 0; q < 2; ++q)
#pragma unroll
            for (int j = 0; j < 8; ++j) v[q][j] = *(const f32x4*)(x + (size_t)(row + q) * DM + (j * 64 + lane) * 4);
#pragma unroll
        for (int q = 0; q < 2; ++q) {
#pragma unroll
            for (int j = 0; j < 8; ++j) ss[q] += v[q][j][0] * v[q][j][0] + v[q][j][1] * v[q][j][1] + v[q][j][2] * v[q][j][2] + v[q][j][3] * v[q][j][3];
            ss[q] = wave_sum(ss[q]); const float rs = rsqrtf(ss[q] * (1.f / DM) + 1e-6f);
#pragma unroll
            for (int j = 0; j < 8; ++j) {
                const f32x4 gg = gq[j]; u32x2 w;
                w.x = cvt_pk_bf16(v[q][j][0] * rs * gg[0], v[q][j][1] * rs * gg[1]); w.y = cvt_pk_bf16(v[q][j][2] * rs * gg[2], v[q][j][3] * rs * gg[3]);
                *(u32x2*)(out + (size_t)(row + q) * DM + (j * 64 + lane) * 4) = w;
            }
        }
    }
}

#define TT_DECODE(it_, S0, S1, DST, MODE, KK, NS, KT, NTT) do { \
    constexpr int N0_ = 32 * 44, N1_ = 32 * 16, N2_ = 32 * 88; const int i_ = (it_); \
    if (i_ < N0_) { S0 = S1 = p.in[I_WIN] + (size_t)layer * DM * NIN; DST = (bf16_t*)(p.ws + WS_WIN); MODE = 0; KK = DM; NS = NIN; KT = i_ / 44; NTT = i_ % 44; } \
    else if (i_ < N0_ + N1_) { const int j_ = i_ - N0_; S0 = S1 = p.in[I_WOUT] + (size_t)layer * DM * DM; DST = (bf16_t*)(p.ws + WS_WOUT); MODE = 0; KK = DM; NS = DM; KT = j_ / 16; NTT = j_ % 16; } \
    else if (i_ < N0_ + N1_ + N2_) { const int j_ = i_ - N0_ - N1_; S0 = p.in[I_WG] + (size_t)layer * DM * DFF; S1 = p.in[I_WU] + (size_t)layer * DM * DFF; DST = (bf16_t*)(p.ws + WS_WGU); MODE = 1; KK = DM; NS = DFF; KT = j_ / 88; NTT = j_ % 88; } \
    else { const int j_ = i_ - N0_ - N1_ - N2_; S0 = S1 = p.in[I_WD] + (size_t)layer * DFF * DM; DST = (bf16_t*)(p.ws + WS_WDN); MODE = 0; KK = DFF; NS = DM; KT = j_ / 16; NTT = j_ % 16; } } while (0)
__device__ __forceinline__ void phase_weights(const Params& p, const int layer, LAS unsigned char* lds) {
    LAS float* tile = (LAS float*)lds;
    constexpr int NT = 32 * 44;
    int Gs = gridDim.x; asm volatile("" : "+s"(Gs));
    int it = blockIdx.x; if (it >= NT) return;
    f32x4 v[4]; bool ok;
    { const float* s0; const float* s1; bf16_t* dst; int mode, K, Ns, kt, nt; TT_DECODE(it, s0, s1, dst, mode, K, Ns, kt, nt); tt_load(s0, s1, mode, Ns, kt, nt, v, ok); (void)dst; (void)K; }
    for (;;) {
        tt_to_lds(v, ok, tile);
        __syncthreads();
        const int itn = it + Gs; const bool more = itn < NT;
        if (more) { const float* s0; const float* s1; bf16_t* dst; int mode, K, Ns, kt, nt; TT_DECODE(itn, s0, s1, dst, mode, K, Ns, kt, nt); tt_load(s0, s1, mode, Ns, kt, nt, v, ok); (void)dst; (void)K; }
        { const float* s0; const float* s1; bf16_t* dst; int mode, K, Ns, kt, nt; TT_DECODE(it, s0, s1, dst, mode, K, Ns, kt, nt); tt_store(dst, K, kt, nt, tile); (void)s0; (void)s1; (void)mode; (void)Ns; }
        __syncthreads();
        if (!more) break;
        it = itn;
    }
}
__device__ __forceinline__ void weights_queue(const Params& p, const int layer, LAS unsigned char* lds, unsigned* ctr) {
    LAS float* tile = (LAS float*)lds; volatile LAS int* slot = (volatile LAS int*)(lds + 64 * 132 * 4);
    constexpr int T0 = 32 * 44, NT = 32 * 44 + 32 * 16 + 32 * 88 + 88 * 16, CH = 8;
    for (;;) {
        if (otid() == 0) slot[0] = T0 + CH * (int)__hip_atomic_fetch_add(ctr, 1u, __ATOMIC_RELAXED, __HIP_MEMORY_SCOPE_AGENT);
        __syncthreads();
        const int base = slot[0];
        if (base >= NT) break;
        const int end = base + CH < NT ? base + CH : NT;
        f32x4 v[4]; bool ok;
        { const float* s0; const float* s1; bf16_t* dst; int mode, K, Ns, kt, nt; TT_DECODE(base, s0, s1, dst, mode, K, Ns, kt, nt); tt_load(s0, s1, mode, Ns, kt, nt, v, ok); (void)dst; (void)K; }
        for (int it = base; it < end; ++it) {
            tt_to_lds(v, ok, tile);
            __syncthreads();
            if (it + 1 < end) { const float* s0; const float* s1; bf16_t* dst; int mode, K, Ns, kt, nt; TT_DECODE(it + 1, s0, s1, dst, mode, K, Ns, kt, nt); tt_load(s0, s1, mode, Ns, kt, nt, v, ok); (void)dst; (void)K; }
            { const float* s0; const float* s1; bf16_t* dst; int mode, K, Ns, kt, nt; TT_DECODE(it, s0, s1, dst, mode, K, Ns, kt, nt); tt_store(dst, K, kt, nt, tile); (void)s0; (void)s1; (void)mode; (void)Ns; }
            __syncthreads();
        }
    }
    __syncthreads();
}
__device__ __forceinline__ void store_vt16(bf16_t* dst, const float (&v)[16]) {
    u32x4 w0, w1;
    w0.x = cvt_pk_bf16(v[0], v[1]); w0.y = cvt_pk_bf16(v[2], v[3]); w0.z = cvt_pk_bf16(v[8], v[9]); w0.w = cvt_pk_bf16(v[10], v[11]);
    w1.x = cvt_pk_bf16(v[4], v[5]); w1.y = cvt_pk_bf16(v[6], v[7]); w1.z = cvt_pk_bf16(v[12], v[13]); w1.w = cvt_pk_bf16(v[14], v[15]);
    *(u32x4*)dst = w0; *(u32x4*)(dst + 8) = w1;
}

__device__ __forceinline__ void token_prep_unit(const Params& p, const int layer, const int u) {
    const int lane = otid() & 63, wave = otid() >> 6;
    const int row0 = u * 64 + (wave & 3) * 16; const int b = row0 >> 11, t16 = (row0 & 2047) >> 4;
    const bf16_t* proj = (const bf16_t*)(p.ws + WS_PROJ); float* mix = (float*)(p.ws + WS_MIX);
    if ((wave >> 2) == 0) {
        bf16_t* QN = (bf16_t*)(p.ws + WS_QN); bf16_t* KS = (bf16_t*)(p.ws + WS_KS); bf16_t* KW = (bf16_t*)(p.ws + WS_KW);
        const int d0 = (lane & 7) * 8;
        const f32x4 qg0 = *(const f32x4*)(p.in[I_QG] + layer * 64 + d0), qg1 = *(const f32x4*)(p.in[I_QG] + layer * 64 + d0 + 4);
        const f32x4 kg0 = *(const f32x4*)(p.in[I_KG] + layer * 64 + d0), kg1 = *(const f32x4*)(p.in[I_KG] + layer * 64 + d0 + 4);
        const float* cw = p.in[I_CONV] + (size_t)layer * 3 * 512 + lane * 8;
        const f32x4 c0a = *(const f32x4*)(cw), c0b = *(const f32x4*)(cw + 4), c1a = *(const f32x4*)(cw + 512), c1b = *(const f32x4*)(cw + 516), c2a = *(const f32x4*)(cw + 1024), c2b = *(const f32x4*)(cw + 1028);
        f32x4 z1a, z1b, z2a, z2b;
        if ((row0 & 2047) == 0) { z1a = z1b = z2a = z2b = (f32x4){0.f, 0.f, 0.f, 0.f}; }
        else {
            const bf16_t* P1 = proj + (size_t)(row0 - 1) * NPJ + lane * 8; const bf16_t* P2 = proj + (size_t)(row0 - 2) * NPJ + lane * 8;
            const u32x4 r1c = *(const u32x4*)(P1 + C_CG), r1h = *(const u32x4*)(P1 + C_BH), r2c = *(const u32x4*)(P2 + C_CG), r2h = *(const u32x4*)(P2 + C_BH);
            { const F8 c1 = up8(r1c), h1 = up8(r1h); z1a = c1.a * h1.a; z1b = c1.b * h1.b; }
            { const F8 c2 = up8(r2c), h2 = up8(r2h); z2a = c2.a * h2.a; z2b = c2.b * h2.b; }
        }
#pragma unroll 1
        for (int i0 = 0; i0 < 16; i0 += 4) {
            u32x4 rq[4], rk[4], rcg[4], rbh[4], rbg[4];
            const int l5 = lane & 31, sel = l5 >> 4, cc = (l5 & 15) * 8;
#pragma unroll
            for (int j = 0; j < 4; ++j) {
                const bf16_t* P = proj + (size_t)(row0 + i0 + j) * NPJ;
                rq[j] = *(const u32x4*)(P + lane * 8); rk[j] = *(const u32x4*)(P + (sel ? C_KW : C_KS) + cc);
                rcg[j] = *(const u32x4*)(P + lane * 8 + C_CG); rbh[j] = *(const u32x4*)(P + lane * 8 + C_BH); rbg[j] = *(const u32x4*)(P + lane * 8 + C_BG);
            }
#pragma unroll
            for (int j = 0; j < 4; ++j) {
                const int row = row0 + i0 + j;
                {
                    const F8 q8 = up8(rq[j]); const f32x4 a = q8.a, c = q8.b;
                    float ss = a[0] * a[0] + a[1] * a[1] + a[2] * a[2] + a[3] * a[3] + c[0] * c[0] + c[1] * c[1] + c[2] * c[2] + c[3] * c[3];
                    ss += __shfl_xor(ss, 1); ss += __shfl_xor(ss, 2); ss += __shfl_xor(ss, 4);
                    const float r = rsqrtf(ss * (1.f / 64.f) + 1e-6f); constexpr float QSC = 0.125f * 1.4426950408889634f;
                    *(bf16x8*)(QN + (size_t)row * 512 + lane * 8) = pack8(a[0] * r * qg0[0] * QSC, a[1] * r * qg0[1] * QSC, a[2] * r * qg0[2] * QSC, a[3] * r * qg0[3] * QSC,
                                                                           c[0] * r * qg1[0] * QSC, c[1] * r * qg1[1] * QSC, c[2] * r * qg1[2] * QSC, c[3] * r * qg1[3] * QSC);
                }
                {
                    const F8 k8 = up8(rk[j]); const f32x4 a = k8.a, c = k8.b;
                    float ss = a[0] * a[0] + a[1] * a[1] + a[2] * a[2] + a[3] * a[3] + c[0] * c[0] + c[1] * c[1] + c[2] * c[2] + c[3] * c[3];
                    ss += __shfl_xor(ss, 1); ss += __shfl_xor(ss, 2); ss += __shfl_xor(ss, 4);
                    const float r = rsqrtf(ss * (1.f / 64.f) + 1e-6f);
                    const int tk = row & 2047, gk = cc >> 6, dk = cc & 63;
                    if (lane < 32) *(bf16x8*)((sel ? KW : KS) + ((size_t)((b * 2 + gk) * 64 + (tk >> 5)) * 2048 + (size_t)((dk >> 4) * 64 + ((dk >> 3) & 1) * 32 + (tk & 31)) * 8)) =
                        pack8(a[0] * r * kg0[0], a[1] * r * kg0[1], a[2] * r * kg0[2], a[3] * r * kg0[3], c[0] * r * kg1[0], c[1] * r * kg1[1], c[2] * r * kg1[2], c[3] * r * kg1[3]);
                }
                {
                    const F8 cg8 = up8(rcg[j]), bh8 = up8(rbh[j]), bg8 = up8(rbg[j]);
                    const f32x4 za = cg8.a * bh8.a, zb = cg8.b * bh8.b;
                    const f32x4 ya = c0a * z2a + c1a * z1a + c2a * za, yb = c0b * z2b + c1b * z1b + c2b * zb;
                    *(f32x4*)(mix + (size_t)row * DM + 512 + lane * 8) = bg8.a * ya;
                    *(f32x4*)(mix + (size_t)row * DM + 512 + lane * 8 + 4) = bg8.b * yb;
                    z2a = z1a; z2b = z1b; z1a = za; z1b = zb;
                }
            }
        }
        {
            float v[4][16];
#pragma unroll
            for (int sel = 0; sel < 4; ++sel) {
                const int col = (sel < 2 ? C_VS : C_VW) + (sel & 1) * 64 + lane;
#pragma unroll
                for (int i = 0; i < 16; ++i) v[sel][i] = bf2f(proj[(size_t)(row0 + i) * NPJ + col]);
            }
#pragma unroll
            for (int sel = 0; sel < 4; ++sel)
                store_vt16((bf16_t*)(p.ws + (sel < 2 ? WS_VST : WS_VWT)) + ((size_t)((b * 2 + (sel & 1)) * 128 + t16) * 64 + lane) * 16, v[sel]);
        }
    } else {
        bf16_t* DQ = (bf16_t*)(p.ws + WS_DQ); bf16_t* DK = (bf16_t*)(p.ws + WS_DK); bf16_t* DVT = (bf16_t*)(p.ws + WS_DVT);
#pragma unroll 1
        for (int i0 = 0; i0 < 16; i0 += 8) {
            u32x4 rq[8], rk[8];
#pragma unroll
            for (int j = 0; j < 8; ++j) { const bf16_t* P = proj + (size_t)(row0 + i0 + j) * NPJ + lane * 8; rq[j] = *(const u32x4*)(P + C_DQ); rk[j] = *(const u32x4*)(P + C_DK); }
#pragma unroll
            for (int j = 0; j < 8; ++j) {
                const int row = row0 + i0 + j; const F8 q8 = up8(rq[j]); const f32x4 qa = q8.a, qb = q8.b;
                *(bf16x8*)(DQ + (size_t)row * 512 + lane * 8) = pack8(qa[0] * 0.125f, qa[1] * 0.125f, qa[2] * 0.125f, qa[3] * 0.125f, qb[0] * 0.125f, qb[1] * 0.125f, qb[2] * 0.125f, qb[3] * 0.125f);
                const int tk = row & 2047, hk = lane >> 3, dk = (lane & 7) * 8;
                *(u32x4*)(DK + ((size_t)((b * 8 + hk) * 64 + (tk >> 5)) * 2048 + (size_t)((dk >> 4) * 64 + ((dk >> 3) & 1) * 32 + (tk & 31)) * 8)) = rk[j];
            }
        }
#pragma unroll 1
        for (int h0 = 0; h0 < 8; h0 += 4) {
            float v[4][16];
#pragma unroll
            for (int hh = 0; hh < 4; ++hh)
#pragma unroll
                for (int i = 0; i < 16; ++i) v[hh][i] = bf2f(proj[(size_t)(row0 + i) * NPJ + C_DV + (h0 + hh) * 64 + lane]);
#pragma unroll
            for (int hh = 0; hh < 4; ++hh) store_vt16(DVT + ((size_t)((b * 8 + h0 + hh) * 128 + t16) * 64 + lane) * 16, v[hh]);
        }
    }
}

__device__ __forceinline__ void sgu_unit(const Params& p, const int layer, const int u, LAS unsigned char* lds) {
    const int lane = otid() & 63, wave = otid() >> 6;
    const int hh = (u >> 3) & 1, row0 = ((u & 7) | ((u >> 4) << 3)) * 128;
    const bf16_t* proj = (const bf16_t*)(p.ws + WS_PROJ); float* mix = (float*)(p.ws + WS_MIX);
    LAS bf16_t* vT = (LAS bf16_t*)lds;
    u32x4 rv[16];
#pragma unroll
    for (int i = 0; i < 16; ++i) rv[i] = *(const u32x4*)(proj + (size_t)(row0 + wave * 16 + i) * NPJ + C_CV + lane * 8);
#pragma unroll
    for (int i = 0; i < 16; ++i) {
        const int tk = wave * 16 + i;
        const F8 v8 = up8(rv[i]); const f32x4 a = v8.a, c = v8.b; float gv[8];
#pragma unroll
        for (int j = 0; j < 4; ++j) { gv[j] = gelu_tanh(a[j]); gv[4 + j] = gelu_tanh(c[j]); }
        float s = 0.f;
#pragma unroll
        for (int j = 0; j < 8; ++j) s += gv[j];
        s = wave_sum(s); const float mu = s * (1.f / 512.f); float q = 0.f;
#pragma unroll
        for (int j = 0; j < 8; ++j) { gv[j] -= mu; q += gv[j] * gv[j]; }
        q = wave_sum(q); const float rs = rsqrtf(q * (1.f / 512.f) + 1e-5f);
        if ((lane >> 5) == hh) {
            const int chl = (lane & 31) * 8;
#pragma unroll
            for (int j = 0; j < 8; ++j) vT[(chl + j) * 136 + tk] = bf1(gv[j] * rs);
        }
    }
    __syncthreads();
    const int hl = wave & 3, h = hh * 4 + hl, ph = wave >> 2, ql = lane & 31, hf = lane >> 5;
    const float* W = p.in[I_SGW] + (size_t)(layer * 8 + h) * 128 * 128;
    f32x16 acc[2][2];
#pragma unroll
    for (int a = 0; a < 2; ++a)
#pragma unroll
        for (int c = 0; c < 2; ++c)
#pragma unroll
            for (int r = 0; r < 16; ++r) acc[a][c][r] = 0.f;
#pragma unroll
    for (int ptl = 0; ptl < 2; ++ptl) {
        const int pt = ph * 2 + ptl, prow = pt * 32 + ql;
#pragma unroll 2
        for (int kc = 0; kc <= 2 * pt + 1; ++kc) {
            const int q0 = kc * 16 + hf * 8; const float* wp = W + (size_t)prow * 128 + q0;
            const f32x4 w0 = *(const f32x4*)(wp), w1 = *(const f32x4*)(wp + 4);
            const bf16x8 A = pack8(q0 + 0 <= prow ? w0[0] : 0.f, q0 + 1 <= prow ? w0[1] : 0.f, q0 + 2 <= prow ? w0[2] : 0.f, q0 + 3 <= prow ? w0[3] : 0.f,
                                   q0 + 4 <= prow ? w1[0] : 0.f, q0 + 5 <= prow ? w1[1] : 0.f, q0 + 6 <= prow ? w1[2] : 0.f, q0 + 7 <= prow ? w1[3] : 0.f);
#pragma unroll
            for (int et = 0; et < 2; ++et) {
                const bf16x8 Bv = *(const LAS bf16x8*)(vT + (hl * 64 + et * 32 + ql) * 136 + kc * 16 + hf * 8);
                acc[ptl][et] = mfma32(A, Bv, acc[ptl][et]);
            }
        }
    }
    const float* sb = p.in[I_SGB] + (size_t)(layer * 8 + h) * 128;
#pragma unroll
    for (int ptl = 0; ptl < 2; ++ptl) {
        bf16_t uraw[2][16];
#pragma unroll
        for (int et = 0; et < 2; ++et)
#pragma unroll
            for (int r = 0; r < 16; ++r) uraw[et][r] = proj[(size_t)(row0 + (ph * 2 + ptl) * 32 + (r & 3) + 8 * (r >> 2) + 4 * hf) * NPJ + C_CU + h * 64 + et * 32 + ql];
        float sbv[16];
#pragma unroll
        for (int r = 0; r < 16; ++r) sbv[r] = sb[(ph * 2 + ptl) * 32 + (r & 3) + 8 * (r >> 2) + 4 * hf];
#pragma unroll
        for (int et = 0; et < 2; ++et)
#pragma unroll
            for (int r = 0; r < 16; ++r) {
                const int pr = (ph * 2 + ptl) * 32 + (r & 3) + 8 * (r >> 2) + 4 * hf; const int col = h * 64 + et * 32 + ql;
                mix[(size_t)(row0 + pr) * DM + 1024 + col] = gelu_tanh(bf2f(uraw[et][r])) * (acc[ptl][et][r] + sbv[r]);
            }
    }
    __syncthreads();
}

__device__ __forceinline__ void compress_unit(const Params& p, const int layer, const int u, LAS unsigned char* lds) {
    const int tid = otid(), lane = tid & 63, wave = tid >> 6;
    const int combo = u >> 3, b = combo >> 2, g = (combo >> 1) & 1, kv = combo & 1, n0 = (u & 7) * 16;
    const bf16_t* proj = (const bf16_t*)(p.ws + WS_PROJ);
    LAS float* red = (LAS float*)lds; LAS float* hid = red + 8 * 17 * 64;
    const int colbase = (kv ? C_VC : C_KC) + g * 64;
    const float* W1 = p.in[I_CW1] + (size_t)(layer * 2 + kv) * 2048 * 64;
    const float* pos = p.in[I_CPOS] + (size_t)(layer * 2 + kv) * 2048;
    const int ql = lane & 31, hf = lane >> 5;
    f32x16 acc[2];
#pragma unroll
    for (int ct = 0; ct < 2; ++ct)
#pragma unroll
        for (int r = 0; r < 16; ++r) acc[ct][r] = 0.f;
#pragma unroll 2
    for (int st = 0; st < 16; ++st) {
        const int l = wave * 4 + (st >> 2), d0 = (st & 3) * 16 + hf * 8;
        bf16x8 A = {0, 0, 0, 0, 0, 0, 0, 0};
        if (ql < 16) { const int t = 16 * (n0 + ql) + l; if (t < T) A = *(const bf16x8*)(proj + (size_t)(b * T + t) * NPJ + colbase + d0); }
        else if (ql == 16) { const f32x4 p0 = *(const f32x4*)(pos + l * 64 + d0), p1 = *(const f32x4*)(pos + l * 64 + d0 + 4); A = pack8(p0[0], p0[1], p0[2], p0[3], p1[0], p1[1], p1[2], p1[3]); }
        const float* wp = W1 + (size_t)(l * 64 + d0) * 64 + ql;
#pragma unroll
        for (int ct = 0; ct < 2; ++ct) {
            float w[8];
#pragma unroll
            for (int j = 0; j < 8; ++j) w[j] = wp[j * 64 + ct * 32];
            acc[ct] = mfma32(A, pack8(w[0], w[1], w[2], w[3], w[4], w[5], w[6], w[7]), acc[ct]);
        }
    }
#pragma unroll
    for (int ct = 0; ct < 2; ++ct)
#pragma unroll
        for (int r = 0; r < 16; ++r) {
            const int row = (r & 3) + 8 * (r >> 2) + 4 * hf;
            if (row <= 16) red[(wave * 17 + row) * 64 + ct * 32 + ql] = acc[ct][r];
        }
    __syncthreads();
    for (int o = tid; o < 1024; o += 512) {
        const int r = o >> 6, cc = o & 63; float s = 0.f;
#pragma unroll
        for (int k = 0; k < 8; ++k) s += red[(k * 17 + r) * 64 + cc] + red[(k * 17 + 16) * 64 + cc];
        hid[o] = gelu_tanh(s);
    }
    __syncthreads();
    const float* W2 = p.in[I_CW2] + (size_t)(layer * 2 + kv) * 64 * 64;
    float w2c[64];
#pragma unroll
    for (int k = 0; k < 64; ++k) w2c[k] = W2[k * 64 + lane];
#pragma unroll
    for (int i = 0; i < 2; ++i) {
        const int r = wave + 8 * i; float s = 0.f;
#pragma unroll
        for (int k = 0; k < 64; k += 4) { const f32x4 hv = *(const LAS f32x4*)(hid + r * 64 + k); s += hv[0] * w2c[k] + hv[1] * w2c[k + 1] + hv[2] * w2c[k + 2] + hv[3] * w2c[k + 3]; }
        const int n = n0 + r;
        if (kv == 0) {
            const float ss = wave_sum(s * s); const float o = s * rsqrtf(ss * (1.f / 64.f) + 1e-6f) * p.in[I_KG][layer * 64 + lane];
            ((bf16_t*)(p.ws + WS_KCN))[(size_t)((b * 2 + g) * 4 + (n >> 5)) * 2048 + (size_t)((lane >> 4) * 64 + ((lane >> 3) & 1) * 32 + (n & 31)) * 8 + (lane & 7)] = bf1(o);
        } else {
            ((bf16_t*)(p.ws + WS_VCT))[(((size_t)(b * 2 + g) * 8 + (n >> 4)) * 64 + lane) * 16 + slot16(n & 15)] = bf1(s);
        }
    }
    __syncthreads();
}
__device__ __forceinline__ f32x16 st_tile(const bf16_t* __restrict__ kp  , const int ldk, const bf16x8 (&qf)[4], const int ql, const int hf) {
    f32x16 s;
#pragma unroll
    for (int r = 0; r < 16; ++r) s[r] = 0.f;
#pragma unroll
    for (int kk = 0; kk < 4; ++kk) { const bf16x8 kf = *(const bf16x8*)(kp + (size_t)ql * ldk + kk * 16 + hf * 8); s = mfma32(kf, qf[kk], s); }
    return s;
}
__device__ __forceinline__ void pv_tile(const bf16_t* __restrict__ vt, const f32x16& pm, f32x16 (&o)[2], const int ql, const int hf) {
#pragma unroll
    for (int kc = 0; kc < 2; ++kc) {
        const bf16x8 pb = pack8(pm[8 * kc + 0], pm[8 * kc + 1], pm[8 * kc + 2], pm[8 * kc + 3], pm[8 * kc + 4], pm[8 * kc + 5], pm[8 * kc + 6], pm[8 * kc + 7]);
#pragma unroll
        for (int dt = 0; dt < 2; ++dt) { const bf16x8 vf = *(const bf16x8*)(vt + ((size_t)(kc * 64 + dt * 32 + ql)) * 16 + hf * 8); o[dt] = mfma32(vf, pb, o[dt]); }
    }
}
__device__ __forceinline__ void osm_tile(f32x16& s, float& m, float& l, f32x16 (&o)[2], const bf16_t* __restrict__ vt, const int ql, const int hf) {
    float mx = s[0];
#pragma unroll
    for (int r = 1; r < 16; ++r) mx = fmaxf(mx, s[r]);
    mx = fmaxf(mx, __shfl_xor(mx, 32));
    const float mn = fmaxf(m, mx); const float alpha = __expf(m - mn); float ps = 0.f;
#pragma unroll
    for (int r = 0; r < 16; ++r) { const float pv = s[r] > -1e29f ? __expf(s[r] - mn) : 0.f; s[r] = pv; ps += pv; }
    l = l * alpha + ps; m = mn;
#pragma unroll
    for (int dt = 0; dt < 2; ++dt)
#pragma unroll
        for (int r = 0; r < 16; ++r) o[dt][r] *= alpha;
    pv_tile(vt, s, o, ql, hf);
}

#define LOADK4L(dst, kptr, ld) do { _Pragma("unroll") for (int kk_ = 0; kk_ < 4; ++kk_) dst[kk_] = *(const bf16x8*)((kptr) + (size_t)ql * (ld) + kk_ * 16 + hf * 8); } while (0)
#define LOADK4F(dst, tptr) do { _Pragma("unroll") for (int kk_ = 0; kk_ < 4; ++kk_) dst[kk_] = *(const bf16x8*)((tptr) + (size_t)(kk_ * 64 + hf * 32 + ql) * 8); } while (0)
#define PIN4(a) do { _Pragma("unroll") for (int i_ = 0; i_ < 4; ++i_) asm volatile("" : "+v"(a[i_])); } while (0)
#define COPY4(d, s_) do { _Pragma("unroll") for (int i_ = 0; i_ < 4; ++i_) d[i_] = s_[i_]; } while (0)
#define LOADV4(dst, vptr) do { _Pragma("unroll") for (int i_ = 0; i_ < 4; ++i_) dst[i_] = *(const bf16x8*)((vptr) + (size_t)(((i_ >> 1) * 64 + (i_ & 1) * 32 + ql) * 16 + hf * 8)); } while (0)
constexpr int TS_N = 2080, TW_N = 576, TBL_H = TS_N + TW_N, TBL_ALL = 8 * TBL_H;
constexpr float LOG2E = 1.4426950408889634f;
__device__ __forceinline__ float ex2(float x) { return __builtin_amdgcn_exp2f(x); }

__device__ __forceinline__ void cmp_unit(const Params& p, const int un, const LAS float* tbl, LAS float* impL  , LAS float* impT  ) {
    const int lane = otid() & 63, ql = lane & 31, hf = lane >> 5;
    const int bg = un & 15, qt = 63 - (un >> 4), b = bg >> 1, g = bg & 1, q0 = qt * 32, tq = q0 + ql; const size_t rowq = (size_t)b * T + tq;
    const bf16_t* proj = (const bf16_t*)(p.ws + WS_PROJ); float* mix = (float*)(p.ws + WS_MIX);
    const bf16_t* QN = (const bf16_t*)(p.ws + WS_QN);
    const bf16_t* Kc = (const bf16_t*)(p.ws + WS_KCN) + (size_t)(b * 2 + g) * 4 * 2048;
    const bf16_t* Vc = (const bf16_t*)(p.ws + WS_VCT) + (size_t)(b * 2 + g) * 8 * 64 * 16;
#pragma unroll
    for (int a = 0; a < 16; ++a) impL[a * 64 + lane] = 0.f;
    bf16_t graw[4];
#pragma unroll
    for (int r4 = 0; r4 < 4; ++r4) graw[r4] = proj[rowq * NPJ + C_AG + (g * 4 + r4) * 3 + 0];
    bf16x8 kA[4], kB[4], vA[4], vB[4];
    LOADK4F(kA, Kc); LOADK4F(kB, Kc + 2048); LOADV4(vA, Vc); LOADV4(vB, Vc + (size_t)2 * 1024);
    PIN4(kA); PIN4(kB); PIN4(vA); PIN4(vB);
    for (int r4 = 0; r4 < 4; ++r4) {
        const int hq = g * 4 + r4; const LAS float* bl = tbl + hq * TBL_H;
        bf16x8 qf[4];
#pragma unroll
        for (int kk = 0; kk < 4; ++kk) qf[kk] = *(const bf16x8*)(QN + rowq * 512 + hq * 64 + kk * 16 + hf * 8);
        float l = 0.f;
        f32x16 o[2];
#pragma unroll
        for (int dt = 0; dt < 2; ++dt)
#pragma unroll
            for (int r = 0; r < 16; ++r) o[dt][r] = 0.f;
        float prev_tile = 0.f;
#pragma unroll 1
        for (int pi = 0; pi < 2; ++pi) {
#pragma unroll
            for (int e = 0; e < 2; ++e) {
                const int kt = 2 * pi + e, ktn = (kt + 2) & 3;
                f32x16 s;
#pragma unroll
                for (int r = 0; r < 16; ++r) s[r] = 0.f;
                if (e == 0) {
#pragma unroll
                    for (int kk = 0; kk < 4; ++kk) s = mfma32(kA[kk], qf[kk], s);
                    LOADK4F(kA, Kc + (size_t)ktn * 2048);
                } else {
#pragma unroll
                    for (int kk = 0; kk < 4; ++kk) s = mfma32(kB[kk], qf[kk], s);
                    LOADK4F(kB, Kc + (size_t)ktn * 2048);
                }
                float ps = 0.f;
#pragma unroll
                for (int r = 0; r < 16; ++r) {
                    const int di = tq + 1 - 16 * (kt * 32 + (r & 3) + 8 * (r >> 2) + 4 * hf);
                    s[r] = ex2(s[r] + bl[di > 0 ? di : 0]); ps += s[r];
                }
                l += ps;
                float oth[4];
#pragma unroll
                for (int rg = 0; rg < 4; ++rg) oth[rg] = __shfl_xor(s[4 * rg + 3], 32);
#pragma unroll
                for (int rg = 0; rg < 4; ++rg) {
                    const float prev = hf ? oth[rg] : (rg > 0 ? oth[rg > 0 ? rg - 1 : 0] : prev_tile);
                    impT[(kt * 4 + rg) * 64 + lane] = s[4 * rg] + s[4 * rg + 1] + s[4 * rg + 2] + 0.5f * s[4 * rg + 3] + 0.5f * prev;
                }
                prev_tile = oth[3];
#pragma unroll
                for (int kc = 0; kc < 2; ++kc) {
                    const bf16x8 pb = pack8(s[8 * kc + 0], s[8 * kc + 1], s[8 * kc + 2], s[8 * kc + 3], s[8 * kc + 4], s[8 * kc + 5], s[8 * kc + 6], s[8 * kc + 7]);
#pragma unroll
                    for (int dt = 0; dt < 2; ++dt) o[dt] = mfma32(e == 0 ? vA[kc * 2 + dt] : vB[kc * 2 + dt], pb, o[dt]);
                }
                if (e == 0) LOADV4(vA, Vc + (size_t)(ktn * 2) * 1024); else LOADV4(vB, Vc + (size_t)(ktn * 2) * 1024);
            }
        }
        l += __shfl_xor(l, 32);
        const float inv = l > 0.f ? 1.f / l : 0.f;
#pragma unroll
        for (int a = 0; a < 16; ++a) impL[a * 64 + lane] += impT[a * 64 + lane] * inv;
#pragma unroll
        for (int dt = 0; dt < 2; ++dt)
#pragma unroll
            for (int r = 0; r < 16; ++r) o[dt][r] *= inv;
        const float g0 = sigmoidf_(bf2f(graw[r4]));
#pragma unroll
        for (int dt = 0; dt < 2; ++dt)
#pragma unroll
            for (int rg = 0; rg < 4; ++rg)
                *(f32x4*)(mix + rowq * DM + hq * 64 + dt * 32 + 8 * rg + 4 * hf) = (f32x4){o[dt][4 * rg] * g0, o[dt][4 * rg + 1] * g0, o[dt][4 * rg + 2] * g0, o[dt][4 * rg + 3] * g0};
    }
    {
        const int cur = tq >> 6; float own[16], oth[16];
#pragma unroll
        for (int a = 0; a < 16; ++a) {
            const int j = 2 * a + hf; const bool forced = (j == 0) || (j == cur) || (j == cur - 1);
            own[a] = j <= cur ? impL[a * 64 + lane] + (forced ? 1000.f : 0.f) : -1e30f;
        }
#pragma unroll
        for (int a = 0; a < 16; ++a) { oth[a] = __shfl_xor(own[a], 32); impL[a * 64 + lane] = own[a]; }
        unsigned bits = 0u;
#pragma unroll 1
        for (int a = 0; a < 16; ++a) {
            int rank = 0; const float y = impL[a * 64 + lane]; const int ao = hf ? a + 1 : a;
#pragma unroll
            for (int c = 0; c < 16; ++c) {
                rank += (own[c] > y || (own[c] == y && c < a)) ? 1 : 0;
                rank += (oth[c] > y || (oth[c] == y && c < ao)) ? 1 : 0;
            }
            const int j = 2 * a + hf;
            if (j <= cur && rank < 16) bits |= 1u << j;
        }
        const unsigned msk = bits | (unsigned)__shfl_xor((int)bits, 32);
        if (hf == 0) ((unsigned*)(p.ws + WS_MSK))[(size_t)(b * 2 + g) * T + tq] = msk;
    }
}

__device__ __forceinline__ void osm3_tile(f32x16& s, float& l, f32x16 (&o)[2], const bf16x8 (&vf)[4]) {
    float ps = 0.f;
#pragma unroll
    for (int r = 0; r < 16; ++r) { s[r] = ex2(s[r]); ps += s[r]; }
    l += ps;
#pragma unroll
    for (int kc = 0; kc < 2; ++kc) {
        const bf16x8 pb = pack8(s[8 * kc + 0], s[8 * kc + 1], s[8 * kc + 2], s[8 * kc + 3], s[8 * kc + 4], s[8 * kc + 5], s[8 * kc + 6], s[8 * kc + 7]);
#pragma unroll
        for (int dt = 0; dt < 2; ++dt) o[dt] = mfma32(vf[kc * 2 + dt], pb, o[dt]);
    }
}
__device__ __forceinline__ void slc_next(unsigned& U, int& j, int& sub, const int q0, const bool first) {
    if (!first) { if (j >= 32) return; if (sub == 0 && j * 64 + 32 <= q0 + 31) { sub = 1; return; } }
    sub = 0; if (U) { j = __builtin_ctz(U); U &= U - 1; } else j = 32;
}
__device__ __forceinline__ void ws_unit(const Params& p, const int b, const int hq, const int qt, const LAS float* tbl) {
    const int lane = otid() & 63, ql = lane & 31, hf = lane >> 5;
    const int g = hq >> 2, q0 = qt * 32, tq = q0 + ql; const size_t rowq = (size_t)b * T + tq;
    const bf16_t* proj = (const bf16_t*)(p.ws + WS_PROJ); float* mix = (float*)(p.ws + WS_MIX);
    const bf16_t* KSb = (const bf16_t*)(p.ws + WS_KS) + (size_t)(b * 2 + g) * 64 * 2048;
    const bf16_t* KWb = (const bf16_t*)(p.ws + WS_KW) + (size_t)(b * 2 + g) * 64 * 2048;
    const bf16_t* VSb = (const bf16_t*)(p.ws + WS_VST) + (size_t)(b * 2 + g) * 128 * 64 * 16;
    const bf16_t* VWb = (const bf16_t*)(p.ws + WS_VWT) + (size_t)(b * 2 + g) * 128 * 64 * 16;
    const LAS float* tS = tbl + hq * TBL_H; const LAS float* tW = tS + TS_N;
    const unsigned msk = ((const unsigned*)(p.ws + WS_MSK))[(size_t)(b * 2 + g) * T + tq];
    bf16x8 qf[4];
#pragma unroll
    for (int kk = 0; kk < 4; ++kk) qf[kk] = *(const bf16x8*)((const bf16_t*)(p.ws + WS_QN) + rowq * 512 + hq * 64 + kk * 16 + hf * 8);
    const float graw_s = bf2f(proj[rowq * NPJ + C_AG + hq * 3 + 1]), graw_w = bf2f(proj[rowq * NPJ + C_AG + hq * 3 + 2]);
    f32x16 o[2]; float l = 0.f;
#pragma unroll
    for (int dt = 0; dt < 2; ++dt)
#pragma unroll
        for (int r = 0; r < 16; ++r) o[dt][r] = 0.f;
    bf16x8 kA[4], kB[4], vA[4], vB[4];
    {
        const int ktlo = (q0 > 511 ? q0 - 511 : 0) >> 5;
        LOADK4F(kA, KWb + (size_t)ktlo * 2048); LOADV4(vA, VWb + (size_t)(ktlo * 2) * 1024);
        { const int t1 = ktlo < qt ? ktlo + 1 : qt; LOADK4F(kB, KWb + (size_t)t1 * 2048); LOADV4(vB, VWb + (size_t)(t1 * 2) * 1024); }
        PIN4(kA); PIN4(vA); PIN4(kB); PIN4(vB);
        for (int kt = ktlo; kt <= qt; kt += 2) {
            const int ka = kt + 2 < qt ? kt + 2 : qt, kb = kt + 3 < qt ? kt + 3 : qt;
            {
                f32x16 s;
#pragma unroll
                for (int r = 0; r < 16; ++r) s[r] = 0.f;
#pragma unroll
                for (int kk = 0; kk < 4; ++kk) s = mfma32(kA[kk], qf[kk], s);
                LOADK4F(kA, KWb + (size_t)ka * 2048);
                const LAS float* tb = tW + (tq - kt * 32 + 5 - 4 * hf);
#pragma unroll
                for (int r = 0; r < 16; ++r) s[r] += tb[27 - (r & 3) - 8 * (r >> 2)];
                osm3_tile(s, l, o, vA);
                LOADV4(vA, VWb + (size_t)(ka * 2) * 1024);
            }
            {
                const bool real = kt + 1 <= qt;
                f32x16 s;
#pragma unroll
                for (int r = 0; r < 16; ++r) s[r] = 0.f;
#pragma unroll
                for (int kk = 0; kk < 4; ++kk) s = mfma32(kB[kk], qf[kk], s);
                LOADK4F(kB, KWb + (size_t)kb * 2048);
                const LAS float* tb = real ? tW + (tq - (kt + 1) * 32 + 5 - 4 * hf) : tS;
#pragma unroll
                for (int r = 0; r < 16; ++r) s[r] += tb[27 - (r & 3) - 8 * (r >> 2)];
                osm3_tile(s, l, o, vB);
                LOADV4(vB, VWb + (size_t)(kb * 2) * 1024);
            }
        }
        const float lt = l + __shfl_xor(l, 32); const float sc = (lt > 0.f ? 1.f / lt : 0.f) * sigmoidf_(graw_w);
        f32x4 c[2][4];
#pragma unroll
        for (int dt = 0; dt < 2; ++dt)
#pragma unroll
            for (int rg = 0; rg < 4; ++rg) c[dt][rg] = *(const f32x4*)(mix + rowq * DM + hq * 64 + dt * 32 + 8 * rg + 4 * hf);
#pragma unroll
        for (int dt = 0; dt < 2; ++dt)
#pragma unroll
            for (int rg = 0; rg < 4; ++rg)
                *(f32x4*)(mix + rowq * DM + hq * 64 + dt * 32 + 8 * rg + 4 * hf) = (f32x4){c[dt][rg][0] + o[dt][4 * rg] * sc, c[dt][rg][1] + o[dt][4 * rg + 1] * sc, c[dt][rg][2] + o[dt][4 * rg + 2] * sc, c[dt][rg][3] + o[dt][4 * rg + 3] * sc};
    }
    {
        l = 0.f;
#pragma unroll
        for (int dt = 0; dt < 2; ++dt)
#pragma unroll
            for (int r = 0; r < 16; ++r) o[dt][r] = 0.f;
        unsigned U = msk;
#pragma unroll
        for (int off = 1; off < 32; off <<= 1) U |= (unsigned)__shfl_xor((int)U, off);
        U = (unsigned)__builtin_amdgcn_readfirstlane((int)U);
        int j0 = 32, s0 = 0; slc_next(U, j0, s0, q0, true);
        int j1 = j0, s1 = s0; slc_next(U, j1, s1, q0, false);
        int j2 = j1, s2 = s1; slc_next(U, j2, s2, q0, false);
        int j3 = j2, s3 = s2; slc_next(U, j3, s3, q0, false);
        if (j0 < 32) {
            const int ka = j0 * 64 + s0 * 32, kb = j1 < 32 ? j1 * 64 + s1 * 32 : ka;
            LOADK4F(kA, KSb + (size_t)(ka >> 5) * 2048); LOADV4(vA, VSb + (size_t)(ka >> 4) * 1024); LOADK4F(kB, KSb + (size_t)(kb >> 5) * 2048); LOADV4(vB, VSb + (size_t)(kb >> 4) * 1024);
            PIN4(kA); PIN4(vA); PIN4(kB); PIN4(vB);
        }
        while (j0 < 32) {
            const int k0 = j0 * 64 + s0 * 32, k1 = j1 * 64 + s1 * 32;
            const int k2 = j2 < 32 ? j2 * 64 + s2 * 32 : k0, k3 = j3 < 32 ? j3 * 64 + s3 * 32 : k0;
            {
                const float madd = ((msk >> j0) & 1u) ? 0.f : -1e30f;
                f32x16 s;
#pragma unroll
                for (int r = 0; r < 16; ++r) s[r] = madd;
#pragma unroll
                for (int kk = 0; kk < 4; ++kk) s = mfma32(kA[kk], qf[kk], s);
                LOADK4F(kA, KSb + (size_t)(k2 >> 5) * 2048);
                const LAS float* tb = tS + (tq - k0 + 5 - 4 * hf);
#pragma unroll
                for (int r = 0; r < 16; ++r) s[r] += tb[27 - (r & 3) - 8 * (r >> 2)];
                osm3_tile(s, l, o, vA);
                LOADV4(vA, VSb + (size_t)(k2 >> 4) * 1024);
            }
            {
                const bool real = j1 < 32;
                const float madd = (real && ((msk >> (j1 & 31)) & 1u)) ? 0.f : -1e30f;
                f32x16 s;
#pragma unroll
                for (int r = 0; r < 16; ++r) s[r] = madd;
#pragma unroll
                for (int kk = 0; kk < 4; ++kk) s = mfma32(kB[kk], qf[kk], s);
                LOADK4F(kB, KSb + (size_t)(k3 >> 5) * 2048);
                const LAS float* tb = real ? tS + (tq - k1 + 5 - 4 * hf) : tS;
#pragma unroll
                for (int r = 0; r < 16; ++r) s[r] += tb[27 - (r & 3) - 8 * (r >> 2)];
                osm3_tile(s, l, o, vB);
                LOADV4(vB, VSb + (size_t)(k3 >> 4) * 1024);
            }
            j0 = j2; s0 = s2; j1 = j3; s1 = s3;
            j2 = j3; s2 = s3; slc_next(U, j2, s2, q0, false);
            j3 = j2; s3 = s2; slc_next(U, j3, s3, q0, false);
        }
        const float lt = l + __shfl_xor(l, 32); const float sc = (lt > 0.f ? 1.f / lt : 0.f) * sigmoidf_(graw_s);
        f32x4 c[2][4];
#pragma unroll
        for (int dt = 0; dt < 2; ++dt)
#pragma unroll
            for (int rg = 0; rg < 4; ++rg) c[dt][rg] = *(const f32x4*)(mix + rowq * DM + hq * 64 + dt * 32 + 8 * rg + 4 * hf);
#pragma unroll
        for (int dt = 0; dt < 2; ++dt)
#pragma unroll
            for (int rg = 0; rg < 4; ++rg)
                *(f32x4*)(mix + rowq * DM + hq * 64 + dt * 32 + 8 * rg + 4 * hf) = (f32x4){c[dt][rg][0] + o[dt][4 * rg] * sc, c[dt][rg][1] + o[dt][4 * rg + 1] * sc, c[dt][rg][2] + o[dt][4 * rg + 2] * sc, c[dt][rg][3] + o[dt][4 * rg + 3] * sc};
    }
}

__device__ __forceinline__ void sb_unit(const Params& p, const int b, const int h, const int qt) {
    const int lane = otid() & 63, ql = lane & 31, hf = lane >> 5;
    const int q0 = qt * 32, tq = q0 + ql; const size_t rowq = (size_t)b * T + tq;
    float* mix = (float*)(p.ws + WS_MIX);
    const bf16_t* DQ = (const bf16_t*)(p.ws + WS_DQ);
    const bf16_t* DKb = (const bf16_t*)(p.ws + WS_DK) + (size_t)(b * 8 + h) * 64 * 2048;
    const bf16_t* DVb = (const bf16_t*)(p.ws + WS_DVT) + (size_t)(b * 8 + h) * 128 * 64 * 16;
    bf16x8 qf[4];
#pragma unroll
    for (int kk = 0; kk < 4; ++kk) qf[kk] = *(const bf16x8*)(DQ + rowq * 512 + h * 64 + kk * 16 + hf * 8);
    f32x16 o[2];
#pragma unroll
    for (int dt = 0; dt < 2; ++dt)
#pragma unroll
        for (int r = 0; r < 16; ++r) o[dt][r] = 0.f;
    float carry = 0.f;
    bf16x8 kA[4], kB[4], vA[4];
    LOADK4F(kA, DKb + (size_t)qt * 2048);
    PIN4(kA);
    for (int kt = qt; kt >= 0; --kt) {
        const int k0 = kt * 32, kp = kt > 0 ? kt - 1 : 0;
        LOADK4F(kB, DKb + (size_t)kp * 2048); LOADV4(vA, DVb + (size_t)(kt * 2) * 1024);
        f32x16 s;
#pragma unroll
        for (int r = 0; r < 16; ++r) s[r] = 0.f;
#pragma unroll
        for (int kk = 0; kk < 4; ++kk) s = mfma32(kA[kk], qf[kk], s);
        float lm[16];
#pragma unroll
        for (int r = 0; r < 16; ++r) {
            const int key = k0 + (r & 3) + 8 * (r >> 2) + 4 * hf; const bool valid = key < tq; const float z = s[r];
            const float sp = fmaxf(z, 0.f) + __logf(1.f + __expf(-fabsf(z)));
            lm[r] = valid ? -sp : 0.f; s[r] = valid ? z - sp : -1e30f;
        }
        float G[4], Go[4];
#pragma unroll
        for (int rg = 0; rg < 4; ++rg) { G[rg] = (lm[4 * rg] + lm[4 * rg + 1]) + (lm[4 * rg + 2] + lm[4 * rg + 3]); Go[rg] = __shfl_xor(G[rg], 32); }
        float after = carry;
#pragma unroll
        for (int rg = 3; rg >= 0; --rg) {
            float tail = after + (hf ? 0.f : Go[rg]);
#pragma unroll
            for (int j = 3; j >= 0; --j) { const int r = 4 * rg + j; const float a = s[r] > -1e29f ? __expf(s[r] + tail) : 0.f; tail += lm[r]; s[r] = a; }
            after += G[rg] + Go[rg];
        }
        carry = after;
#pragma unroll
        for (int kc = 0; kc < 2; ++kc) {
            const bf16x8 pb = pack8(s[8 * kc + 0], s[8 * kc + 1], s[8 * kc + 2], s[8 * kc + 3], s[8 * kc + 4], s[8 * kc + 5], s[8 * kc + 6], s[8 * kc + 7]);
#pragma unroll
            for (int dt = 0; dt < 2; ++dt) o[dt] = mfma32(vA[kc * 2 + dt], pb, o[dt]);
        }
        COPY4(kA, kB);
        if (__all(carry < -105.f ? 1 : 0)) break;
    }
#pragma unroll
    for (int dt = 0; dt < 2; ++dt)
#pragma unroll
        for (int rg = 0; rg < 4; ++rg)
            *(f32x4*)(mix + rowq * DM + 1536 + h * 64 + dt * 32 + 8 * rg + 4 * hf) = (f32x4){o[dt][4 * rg], o[dt][4 * rg + 1], o[dt][4 * rg + 2], o[dt][4 * rg + 3]};
}

__device__ __forceinline__ int rel_bucket_dev(const int n) {
    if (n < 16) return n;
    const float nf = (float)n;
    int large = 16 + (int)(logf(nf / 16.f) / 4.1588830833596715f * 16.f);
    return large < 31 ? large : 31;
}
#define XB_TMO      128
#define XB_XCNT(j)  (256  + 64 * (j))
#define XB_XSUB(j)  (1280 + 64 * (j))
#define XB_XGEN(j)  (2304 + 64 * (j))
#define XB_TOP      3328
#define XB_TOPGEN   3392
#define XCD_BAR_WORDS 3456
#define XB_SPIN_CAP (1u << 18)

__device__ __forceinline__ unsigned xb_ld(unsigned* p)              { return __hip_atomic_load(p, __ATOMIC_RELAXED, __HIP_MEMORY_SCOPE_AGENT); }
__device__ __forceinline__ unsigned xb_add(unsigned* p, unsigned v) { return __hip_atomic_fetch_add(p, v, __ATOMIC_RELAXED, __HIP_MEMORY_SCOPE_AGENT); }
__device__ __forceinline__ unsigned xb_xcc_id() { return (unsigned)__builtin_amdgcn_s_getreg((3 << 11) | 20) & 0xFu; }
#define XB_SPIN(cond, bar) do { unsigned _sp = 0; while (cond) { __builtin_amdgcn_s_sleep(1); \
    if ((++_sp & 255u) == 0u) { if (xb_ld(&(bar)[XB_TMO])) break; if (_sp > XB_SPIN_CAP) { atomicAdd(&(bar)[XB_TMO], 1u); break; } } } } while (0)

struct XcdBarrier {
    unsigned* bar; unsigned x;
    volatile LAS unsigned* st;
};

__device__ __forceinline__ XcdBarrier xcd_barrier_post(unsigned* bar, volatile LAS unsigned* st) {
    XcdBarrier b; b.bar = bar; b.x = xb_xcc_id(); b.st = st;
    if (threadIdx.x == 0) (void)xb_add(&bar[XB_XCNT(b.x)], 1u);
    return b;
}
__device__ __forceinline__ void xcd_barrier_complete(unsigned* bar, unsigned x, unsigned& nloc, unsigned& nx) {
    const unsigned G = gridDim.x * gridDim.y * gridDim.z;
    unsigned sum, cnt, mine, sp = 0u;
    for (;;) {
        sum = 0u; cnt = 0u; mine = 0u;
#pragma unroll
        for (unsigned j = 0; j < 16; ++j) { const unsigned c = xb_ld(&bar[XB_XCNT(j)]); sum += c; cnt += (c > 0u) ? 1u : 0u; mine = (j == x) ? c : mine; }
        if (sum == G) break;
        __builtin_amdgcn_s_sleep(1);
        if ((++sp & 255u) == 0u) { if (xb_ld(&bar[XB_TMO])) break; if (sp > XB_SPIN_CAP) { atomicAdd(&bar[XB_TMO], 1u); break; } }
    }
    nloc = mine > 0u ? mine : 1u; nx = cnt > 0u ? cnt : 1u;
}

__device__ __forceinline__ void xcd_barrier(const XcdBarrier& b) {
    asm volatile("s_waitcnt vmcnt(0)" ::: "memory");
    __syncthreads();
    if (threadIdx.x == 0) {
        unsigned* bar = b.bar;
        __builtin_amdgcn_s_waitcnt(0);
        unsigned nloc = b.st[0], nx = b.st[1];
        if (nloc == 0u) { xcd_barrier_complete(bar, b.x, nloc, nx); b.st[0] = nloc; b.st[1] = nx; }
        const unsigned old = xb_add(&bar[XB_XSUB(b.x)], 1u);
        const unsigned gen = old / nloc;
        if (old + 1u == (gen + 1u) * nloc) {
            __builtin_amdgcn_fence(__ATOMIC_RELEASE, "agent");
            asm volatile("s_waitcnt vmcnt(0)" ::: "memory");
            const unsigned og = xb_add(&bar[XB_TOP], 1u);
            const unsigned tg = og / nx;
            if (og + 1u == (tg + 1u) * nx) xb_add(&bar[XB_TOPGEN], 1u);
            else XB_SPIN(xb_ld(&bar[XB_TOPGEN]) == tg, bar);
            __builtin_amdgcn_fence(__ATOMIC_ACQUIRE, "agent");
            xb_add(&bar[XB_XGEN(b.x)], 1u);
            asm volatile("s_waitcnt vmcnt(0)" ::: "memory");
        } else {
            XB_SPIN(xb_ld(&bar[XB_XGEN(b.x)]) == gen, bar);
            __builtin_amdgcn_fence(__ATOMIC_ACQUIRE, "agent");
            asm volatile("s_waitcnt vmcnt(0)" ::: "memory");
        }
    }
    __syncthreads();
}

__device__ __forceinline__ void finalize_rows(const Params& p, const int layer) {
    const int lane = otid() & 63, wave = otid() >> 6;
    const float* mix = (const float*)(p.ws + WS_MIX); bf16_t* out = (bf16_t*)(p.ws + WS_ABUF); const float* gg = p.in[I_GG] + (size_t)layer * DM;
    f32x4 gav[4], gcv[4];
#pragma unroll
    for (int g = 0; g < 4; ++g) { gav[g] = *(const f32x4*)(gg + g * 512 + lane * 8); gcv[g] = *(const f32x4*)(gg + g * 512 + lane * 8 + 4); }
    for (int row = blockIdx.x * 8 + wave; row < MROWS; row += gridDim.x * 8) {
        f32x4 a[4], c[4];
#pragma unroll
        for (int g = 0; g < 4; ++g) { const float* src = mix + (size_t)row * DM + g * 512 + lane * 8; a[g] = *(const f32x4*)(src); c[g] = *(const f32x4*)(src + 4); }
#pragma unroll
        for (int g = 0; g < 4; ++g) {
            float ss = a[g][0] * a[g][0] + a[g][1] * a[g][1] + a[g][2] * a[g][2] + a[g][3] * a[g][3] + c[g][0] * c[g][0] + c[g][1] * c[g][1] + c[g][2] * c[g][2] + c[g][3] * c[g][3];
            ss = wave_sum(ss); const float r = rsqrtf(ss * (1.f / 512.f) + 1e-6f);
            const f32x4 ga = gav[g], gc = gcv[g];
            *(bf16x8*)(out + (size_t)row * DM + g * 512 + lane * 8) = pack8(a[g][0] * r * ga[0], a[g][1] * r * ga[1], a[g][2] * r * ga[2], a[g][3] * r * ga[3], c[g][0] * r * gc[0], c[g][1] * r * gc[1], c[g][2] * r * gc[2], c[g][3] * r * gc[3]);
        }
    }
}

__device__ __forceinline__ int q_grab(unsigned* ctr) {
    int v = 0; if ((otid() & 63) == 0) v = (int)__hip_atomic_fetch_add(ctr, 1u, __ATOMIC_RELAXED, __HIP_MEMORY_SCOPE_AGENT);
    return __builtin_amdgcn_readfirstlane(v);
}
#ifdef PROBE_SEQ
constexpr int PH_PER_LAYER = 10, N_PHASES = 4 * (sizeof((int[])PROBE_SEQ) / sizeof(int));
#else
constexpr int PH_PER_LAYER = 10, N_PHASES = 4 * PH_PER_LAYER;
#endif

__global__ void __launch_bounds__(512, 2) mk_fwd(Params p0) {
    extern __shared__ __attribute__((aligned(16))) unsigned char lds_raw[];
    LAS unsigned char* lds = (LAS unsigned char*)lds_raw;
    cg::grid_group grid = cg::this_grid();
    const int G = gridDim.x, blk = blockIdx.x;
    volatile LAS unsigned* xst = (volatile LAS unsigned*)(lds + LDS_BYTES - 16);
    { const int t0 = otid(); if (t0 < 4) xst[t0] = 0u; }
    __syncthreads();
    XcdBarrier xbar = xcd_barrier_post((unsigned*)(p0.ws + WS_BAR), xst);
    for (int ph = p0.ph_lo; ph < p0.ph_hi; ++ph) {
        if (ph == p0.ph_lo + 1) grid.sync();
        else if (ph > p0.ph_lo) xcd_barrier(xbar);
        Params p = p0;
        {
            typedef __attribute__((address_space(1))) unsigned char* gp_t;
            gp_t gws = (gp_t)p0.ws, gout = (gp_t)p0.out;
            asm volatile("" : "+s"(gws), "+s"(gout));
            p.ws = (unsigned char*)gws; p.out = (float*)gout;
        }
#define LAUNDER_IN(i) do { typedef __attribute__((address_space(1))) unsigned char* gp2_t; gp2_t gi_ = (gp2_t)p0.in[i]; asm volatile("" : "+s"(gi_)); p.in[i] = (const float*)gi_; } while (0)
        bf16_t* abuf = (bf16_t*)(p.ws + WS_ABUF);
#ifdef PROBE_SEQ
        constexpr int kSeq[] = PROBE_SEQ; constexpr int kSeqN = sizeof(kSeq) / sizeof(int);
        const int layer = ph / kSeqN; int sp = 0;
#pragma unroll
        for (int i = 0; i < kSeqN; ++i) if (ph % kSeqN == i) sp = kSeq[i];
#else
        const int layer = ph / PH_PER_LAYER, sp = ph % PH_PER_LAYER;
#endif
#ifdef REPEAT_SP
        for (int rep = 0; rep < ((sp == REPEAT_SP) ? 2 : 1); ++rep) {
        __syncthreads();
#endif
        if (sp == 0) {
            LAUNDER_IN(I_X); LAUNDER_IN(I_NMIX); LAUNDER_IN(I_WIN); LAUNDER_IN(I_WOUT); LAUNDER_IN(I_WG); LAUNDER_IN(I_WU); LAUNDER_IN(I_WD);
#ifndef SKIP_P0
            phase_weights(p, layer, lds);
            rmsnorm_rows(layer == 0 ? p.in[I_X] : p.out, p.in[I_NMIX] + (size_t)layer * DM, abuf);
#endif
        } else if (sp == 1) {
            pg8::Gemm g{abuf, (const bf16_t*)(p.ws + WS_WIN), MROWS, NPJ, DM}; pg8::StaticOrder S; S.init(MROWS, NPJ, G, blk);
            EpiF32 E{(bf16_t*)(p.ws + WS_PROJ), NPJ};
#ifndef SKIP_G1
            pg8::gemm_phase<EpiF32, pg8::StaticOrder, true, true>(lds, g, S, E);
            LAUNDER_IN(I_WOUT); LAUNDER_IN(I_WG); LAUNDER_IN(I_WU); LAUNDER_IN(I_WD);
            weights_queue(p, layer, lds, (unsigned*)(p.ws + WS_BAR + 16384 + 4096) + layer * 16);
#endif
        } else if (sp == 2) {
            LAUNDER_IN(I_QG); LAUNDER_IN(I_KG); LAUNDER_IN(I_CONV); LAUNDER_IN(I_SGW); LAUNDER_IN(I_SGB); LAUNDER_IN(I_CPOS); LAUNDER_IN(I_CW1); LAUNDER_IN(I_CW2); LAUNDER_IN(I_REL);
            for (int u = blk; u < 256; u += G) token_prep_unit(p, layer, u);
            for (int u = blk; u < 256; u += G) sgu_unit(p, layer, u, lds);
            for (int u = blk; u < 256; u += G) compress_unit(p, layer, u, lds);
            {
                const int tid = otid();
                if (blk == 0 && tid < 64) {
                    float gq = fabsf(p.in[I_QG][layer * 64 + tid]), gk = fabsf(p.in[I_KG][layer * 64 + tid]);
                    const float r0 = p.in[I_REL][tid], r1 = p.in[I_REL][tid + 64], r2 = p.in[I_REL][tid + 128], r3 = p.in[I_REL][tid + 192];
                    float bm = fmaxf(fmaxf(fabsf(r0), fabsf(r1)), fmaxf(fabsf(r2), fabsf(r3)));
#pragma unroll
                    for (int o = 1; o < 64; o <<= 1) { gq = fmaxf(gq, __shfl_xor(gq, o)); gk = fmaxf(gk, __shfl_xor(gk, o)); }
#pragma unroll
                    for (int o = 8; o < 64; o <<= 1) bm = fmaxf(bm, __shfl_xor(bm, o));
                    if (tid < 8) ((float*)(p.ws + WS_BAR + 16384 + 16384 - 64))[tid] = fminf(64.f * 0.125f * LOG2E * gq * gk + bm * LOG2E, 60.f);
                }
            }
        } else if (sp == 3) {
            LAUNDER_IN(I_REL);
            const int tid = otid(), wave = __builtin_amdgcn_readfirstlane(tid >> 6);
            LAS float* tbl = (LAS float*)lds; const float* m0g = (const float*)(p.ws + WS_BAR + 16384 + 16384 - 64);
            for (int idx = tid; idx < TBL_ALL; idx += 512) {
                const int h = idx / TBL_H, i = idx - h * TBL_H; const bool isS = i < TS_N; const int dist = (isS ? i : i - TS_N) - 32;
                const bool ok = dist >= 0 && (isS || dist < 512);
                tbl[idx] = ok ? p.in[I_REL][rel_bucket_dev(dist) * 8 + h] * LOG2E - m0g[h] : -1e30f;
            }
            __syncthreads();
            const int gw = wave * G + blk, NW = 8 * G;
            if (NW >= 2048 && (G & 7) == 0) {
                if (gw < 1024) {
#ifndef SKIP_NSA
                    cmp_unit(p, gw, tbl, tbl + TBL_ALL + wave * 1024, tbl + TBL_ALL + 8192 + wave * 1024);
#endif
                }
                unsigned* ctr = (unsigned*)(p.ws + WS_BAR + 16384) + (layer * 8 + (blk & 7)) * 16;
                int u = q_grab(ctr);
                while (u < 512) {
                    const int un = q_grab(ctr);
#ifndef SKIP_SB
                    sb_unit(p, blk & 7, u & 7, 63 - (u >> 3));
#endif
                    u = un;
                }
            } else {
                for (int un = gw; un < 1024; un += NW) cmp_unit(p, un, tbl, tbl + TBL_ALL + wave * 1024, tbl + TBL_ALL + 8192 + wave * 1024);
                for (int ud = gw; ud < 4096; ud += NW) { const int bh = ud & 63; sb_unit(p, bh & 7, bh >> 3, 63 - (ud >> 6)); }
            }
        } else if (sp == 4) {
            const int tid = otid(), wave = __builtin_amdgcn_readfirstlane(tid >> 6);
            const LAS float* tbl = (const LAS float*)lds;
            if ((G & 7) == 0) {
                unsigned* ctr = (unsigned*)(p.ws + WS_BAR + 16384 + 8192) + (layer * 8 + (blk & 7)) * 16;
                volatile LAS int* slot = (volatile LAS int*)(lds + LDS_BYTES - 64);
                for (;;) {
                    if (otid() == 0) slot[0] = (int)__hip_atomic_fetch_add(ctr, 1u, __ATOMIC_RELAXED, __HIP_MEMORY_SCOPE_AGENT);
                    __syncthreads();
                    const int u = slot[0];
                    if (u >= 64) break;
#ifndef SKIP_WS
                    ws_unit(p, blk & 7, (u & 1) * 4 + (wave & 3), 63 - 2 * (u >> 1) - (wave >> 2), tbl);
#endif
                    __syncthreads();
                }
            } else {
                const int gw = wave * G + blk, NW = 8 * G;
                for (int uu = gw; uu < 2048; uu += NW) {
                    const int bh = uu & 63, qa = uu >> 6;
                    ws_unit(p, bh & 7, bh >> 3, 63 - qa, tbl);
                    ws_unit(p, bh & 7, bh >> 3, qa, tbl);
                }
            }
        } else if (sp == 5) {
            LAUNDER_IN(I_GG);
#ifndef SKIP_FIN
            finalize_rows(p, layer);
#endif
        } else if (sp == 6) {
            LAUNDER_IN(I_X);
            pg8::Gemm g{abuf, (const bf16_t*)(p.ws + WS_WOUT), MROWS, DM, DM}; pg8::StaticOrder S; S.init(MROWS, DM, G, blk);
            EpiResid E{layer == 0 ? p.in[I_X] : p.out, p.out, DM};
#ifndef SKIP_G2
            pg8::gemm_phase<EpiResid, pg8::StaticOrder, true, true>(lds, g, S, E);
#endif
        } else if (sp == 7) {
            LAUNDER_IN(I_NFFN);
#ifndef SKIP_RN
            rmsnorm_rows(p.out, p.in[I_NFFN] + (size_t)layer * DM, abuf);
#endif
        } else if (sp == 8) {
            pg8::Gemm g{abuf, (const bf16_t*)(p.ws + WS_WGU), MROWS, NGU, DM}; pg8::StaticOrder S; S.init(MROWS, NGU, G, blk);
            EpiSwiglu E{(bf16_t*)(p.ws + WS_PROJ), DFF};
#ifndef SKIP_G3
            pg8::gemm_phase<EpiSwiglu, pg8::StaticOrder, true, true>(lds, g, S, E);
#endif
        } else {
            pg8::Gemm g{(const bf16_t*)(p.ws + WS_PROJ), (const bf16_t*)(p.ws + WS_WDN), MROWS, DM, DFF}; pg8::StaticOrder S; S.init(MROWS, DM, G, blk);
            EpiResid E{p.out, p.out, DM};
#ifndef SKIP_G2
            pg8::gemm_phase<EpiResid, pg8::StaticOrder, true, true>(lds, g, S, E);
#endif
        }
#ifdef REPEAT_SP
        }
#endif
    }
}

extern "C" void kernel_launch(void* const* d_in, const int* in_sizes, int n_in, void* d_out, int out_size, void* d_ws, size_t ws_size, hipStream_t stream) {
    static int grid_blocks = 0;
    if (!grid_blocks) {
        hipFuncSetAttribute((const void*)mk_fwd, hipFuncAttributeMaxDynamicSharedMemorySize, LDS_BYTES);
        int dev = 0, cus = 0, per_cu = 0;
        hipGetDevice(&dev);
        hipDeviceGetAttribute(&cus, hipDeviceAttributeMultiprocessorCount, dev);
        hipOccupancyMaxActiveBlocksPerMultiprocessor(&per_cu, mk_fwd, 512, LDS_BYTES);
        if (per_cu < 1) fprintf(stderr, "occupancy query returned %d\n", per_cu);
        grid_blocks = cus;
    }
    if (ws_size < WS_END) { fprintf(stderr, "workspace too small: %zu < %zu\n", ws_size, (size_t)WS_END); return; }
    Params p{};
    for (int i = 0; i < 18; ++i) p.in[i] = (const float*)d_in[i];
    p.out = (float*)d_out; p.ws = (unsigned char*)d_ws; p.ph_lo = 0; p.ph_hi = N_PHASES;
    void* args[] = {&p};
    (void)hipMemsetAsync((unsigned char*)d_ws + WS_BAR, 0, 32768, stream);
    hipError_t e = hipLaunchCooperativeKernel((void*)mk_fwd, dim3(grid_blocks), dim3(512), args, LDS_BYTES, stream);
    if (e != hipSuccess) fprintf(stderr, "cooperative launch failed: %s (grid %d)\n", hipGetErrorString(e), grid_blocks);
}
```
